# Optimizing an MI355X kernel written in HIP

```python
import math
import jax, jax.numpy as jnp
from jax import lax
import numpy as np

D_MODEL = 2048
BATCH = 4
SEQ = 4096
DEPTH = 1
DEC_BATCH = 16
DEC_SEQ = 64
PAST_LEN = 2048

CHUNK = 64
Q_BLOCK = 128
MIX_WIDTH = D_MODEL
ATTN_WIDTH = MIX_WIDTH // 2
CONV_CH = MIX_WIDTH - ATTN_WIDTH
N_HEADS = 8
HEAD_DIM = ATTN_WIDTH // (2 * N_HEADS)
KEY_DIM = 2 * HEAD_DIM
VALUE_DIM = 2 * HEAD_DIM
CONV_WIDTH = 3
FFN_DIM = ((8 * D_MODEL // 3 + 255) // 256) * 256
PROJ_DIM = 3 * ATTN_WIDTH + 3 * CONV_CH
ROPE_THETA = 10000.0
EPS = 1e-6

kernel_name = "hybrid_diffattn_shortconv_macaron_step"


def rmsnorm(x, g):
    xf = x.astype(jnp.float32)
    y = xf * lax.rsqrt(jnp.mean(xf * xf, axis=-1, keepdims=True) + EPS)
    return (y * g.astype(jnp.float32)).astype(x.dtype)


def swiglu(x, w_gate, w_up, w_down):
    return (jax.nn.silu(x @ w_gate) * (x @ w_up)) @ w_down


def rope(x, pos):
    half = HEAD_DIM // 2
    inv = ROPE_THETA ** (-jnp.arange(0, HEAD_DIM, 2, dtype=jnp.float32) / HEAD_DIM)
    ang = pos.astype(jnp.float32)[:, None] * inv[None, :]
    cos = jnp.cos(ang)[:, None, None, :]
    sin = jnp.sin(ang)[:, None, None, :]
    xf = x.astype(jnp.float32)
    x1, x2 = xf[..., :half], xf[..., half:]
    return jnp.concatenate([x1 * cos - x2 * sin, x2 * cos + x1 * sin], axis=-1).astype(x.dtype)


def diff_attend(q, k, v, q_pos, k_pos, lam):
    s = jnp.einsum('bqhcd,bkhcd->bhcqk', q, k).astype(jnp.float32) * (HEAD_DIM ** -0.5)
    visible = k_pos[None, :] < (q_pos[:, None] // CHUNK + 1) * CHUNK
    s = jnp.where(visible, s, -jnp.inf)
    p = jax.nn.softmax(s, axis=-1)
    a = p[:, :, 0] - lam * p[:, :, 1]
    return jnp.einsum('bhqk,bkhe->bqhe', a.astype(v.dtype), v)


def prompt_attention(q, k, v, lam):
    b, s = q.shape[0], q.shape[1]
    nb = s // Q_BLOCK
    pos = jnp.arange(s)
    qb = q.reshape(b, nb, Q_BLOCK, N_HEADS, 2, HEAD_DIM).transpose(1, 0, 2, 3, 4, 5)
    pb = pos.reshape(nb, Q_BLOCK)
    out = lax.map(lambda a: diff_attend(a[0], k, v, a[1], pos, lam), (qb, pb))
    return out.transpose(1, 0, 2, 3, 4).reshape(b, s, N_HEADS, VALUE_DIM)


def short_conv(u_hist, conv_w, length):
    return sum(conv_w[j] * u_hist[:, j:j + length] for j in range(CONV_WIDTH))


def trunk_layer(x, pos, k_past, v_past, u_past, ffn1_norm, ffn1_w_gate, ffn1_w_up,
                ffn1_w_down, mix_norm, w_in, lambda_q1, lambda_k1, lambda_q2, lambda_k2,
                subln_gain, conv_w, w_out, ffn2_norm, ffn2_w_gate, ffn2_w_up,
                ffn2_w_down, lambda_init):
    b, length = x.shape[0], x.shape[1]
    x = x + 0.5 * swiglu(rmsnorm(x, ffn1_norm), ffn1_w_gate, ffn1_w_up, ffn1_w_down)
    h = rmsnorm(x, mix_norm)
    proj = h @ w_in
    a_w, c_w = ATTN_WIDTH, CONV_CH
    q, k, v, cb, cc, ch = jnp.split(
        proj, [a_w, 2 * a_w, 3 * a_w, 3 * a_w + c_w, 3 * a_w + 2 * c_w], axis=-1)
    q = rope(q.reshape(b, length, N_HEADS, 2, HEAD_DIM), pos)
    k = rope(k.reshape(b, length, N_HEADS, 2, HEAD_DIM), pos)
    v = v.reshape(b, length, N_HEADS, VALUE_DIM)
    lam = (jnp.exp(jnp.sum(lambda_q1.astype(jnp.float32) * lambda_k1.astype(jnp.float32)))
           - jnp.exp(jnp.sum(lambda_q2.astype(jnp.float32) * lambda_k2.astype(jnp.float32)))
           + lambda_init)
    if k_past is None:
        o = prompt_attention(q, k, v, lam)
    else:
        past = k_past.shape[1]
        k_all = jnp.concatenate([k_past.reshape(b, past, N_HEADS, 2, HEAD_DIM), k], axis=1)
        v_all = jnp.concatenate([v_past, v], axis=1)
        o = diff_attend(q, k_all, v_all, pos, jnp.arange(past + length), lam)
    attn_out = (rmsnorm(o, subln_gain) * (1.0 - lambda_init)).reshape(b, length, ATTN_WIDTH)
    u = cc * ch
    u_hist = jnp.concatenate([u_past, u], axis=1)
    conv_out = cb * short_conv(u_hist, conv_w, length)
    x = x + jnp.concatenate([attn_out, conv_out], axis=-1) @ w_out
    x = x + 0.5 * swiglu(rmsnorm(x, ffn2_norm), ffn2_w_gate, ffn2_w_up, ffn2_w_down)
    new_k = k.reshape(b, length, N_HEADS, KEY_DIM)
    return x, new_k, v, u_hist[:, -(CONV_WIDTH - 1):]


def setup_inputs(seed: int = 0) -> dict:
    key = jax.random.key(seed)
    ks = jax.random.split(key, 24)
    f32 = jnp.float32
    nrm = lambda k, shape, s: jax.random.normal(k, shape, f32) * s
    gain = lambda k, shape: 1.0 + 0.01 * jax.random.normal(k, shape, f32)
    return {
        "x_prompt": nrm(ks[0], (BATCH, SEQ, D_MODEL), 1.0),
        "x_sample": nrm(ks[1], (DEC_BATCH, DEC_SEQ, D_MODEL), 1.0),
        "cache_k": nrm(ks[2], (DEPTH, DEC_BATCH, PAST_LEN, N_HEADS, KEY_DIM), 1.0),
        "cache_v": nrm(ks[3], (DEPTH, DEC_BATCH, PAST_LEN, N_HEADS, VALUE_DIM), 1.0),
        "state_conv": nrm(ks[4], (DEPTH, DEC_BATCH, CONV_WIDTH - 1, CONV_CH), 1.0),
        "ffn1_norm": gain(ks[5], (DEPTH, D_MODEL)),
        "ffn1_w_gate": nrm(ks[6], (DEPTH, D_MODEL, FFN_DIM), D_MODEL ** -0.5),
        "ffn1_w_up": nrm(ks[7], (DEPTH, D_MODEL, FFN_DIM), D_MODEL ** -0.5),
        "ffn1_w_down": nrm(ks[8], (DEPTH, FFN_DIM, D_MODEL), FFN_DIM ** -0.5),
        "mix_norm": gain(ks[9], (DEPTH, D_MODEL)),
        "w_in": nrm(ks[10], (DEPTH, D_MODEL, PROJ_DIM), D_MODEL ** -0.5),
        "lambda_q1": nrm(ks[11], (DEPTH, HEAD_DIM), 0.1),
        "lambda_k1": nrm(ks[12], (DEPTH, HEAD_DIM), 0.1),
        "lambda_q2": nrm(ks[13], (DEPTH, HEAD_DIM), 0.1),
        "lambda_k2": nrm(ks[14], (DEPTH, HEAD_DIM), 0.1),
        "subln_gain": gain(ks[15], (DEPTH, VALUE_DIM)),
        "conv_w": nrm(ks[16], (DEPTH, CONV_WIDTH, CONV_CH), CONV_WIDTH ** -0.5),
        "w_out": nrm(ks[17], (DEPTH, MIX_WIDTH, D_MODEL), MIX_WIDTH ** -0.5),
        "ffn2_norm": gain(ks[18], (DEPTH, D_MODEL)),
        "ffn2_w_gate": nrm(ks[19], (DEPTH, D_MODEL, FFN_DIM), D_MODEL ** -0.5),
        "ffn2_w_up": nrm(ks[20], (DEPTH, D_MODEL, FFN_DIM), D_MODEL ** -0.5),
        "ffn2_w_down": nrm(ks[21], (DEPTH, FFN_DIM, D_MODEL), FFN_DIM ** -0.5),
        "final_norm": gain(ks[22], (D_MODEL,)),
    }


def reference(x_prompt, x_sample, cache_k, cache_v, state_conv, ffn1_norm, ffn1_w_gate,
              ffn1_w_up, ffn1_w_down, mix_norm, w_in, lambda_q1, lambda_k1, lambda_q2,
              lambda_k2, subln_gain, conv_w, w_out, ffn2_norm, ffn2_w_gate, ffn2_w_up,
              ffn2_w_down, final_norm):
    xp, xs = x_prompt, x_sample
    pos_p = jnp.arange(xp.shape[1])
    pos_s = cache_k.shape[2] + jnp.arange(xs.shape[1])
    kp_l, vp_l, cp_l, ks_l, vs_l, cs_l = [], [], [], [], [], []
    for l in range(DEPTH):
        lambda_init = 0.8 - 0.6 * math.exp(-0.3 * l)
        w = (ffn1_norm[l], ffn1_w_gate[l], ffn1_w_up[l], ffn1_w_down[l], mix_norm[l],
             w_in[l], lambda_q1[l], lambda_k1[l], lambda_q2[l], lambda_k2[l],
             subln_gain[l], conv_w[l], w_out[l], ffn2_norm[l], ffn2_w_gate[l],
             ffn2_w_up[l], ffn2_w_down[l], lambda_init)
        u0 = jnp.zeros((xp.shape[0], CONV_WIDTH - 1, CONV_CH), xp.dtype)
        xp, kp, vp, cp = trunk_layer(xp, pos_p, None, None, u0, *w)
        xs, ksn, vsn, csn = trunk_layer(xs, pos_s, cache_k[l], cache_v[l], state_conv[l], *w)
        kp_l.append(kp); vp_l.append(vp); cp_l.append(cp)
        ks_l.append(ksn); vs_l.append(vsn); cs_l.append(csn)
    y_prompt = rmsnorm(xp, final_norm)
    y_sample = rmsnorm(xs, final_norm)
    k_prompt = jnp.stack(kp_l)
    v_prompt = jnp.stack(vp_l)
    conv_prompt = jnp.stack(cp_l)
    k_sample = jnp.stack(ks_l)
    v_sample = jnp.stack(vs_l)
    conv_sample = jnp.stack(cs_l)
    return (y_prompt, y_sample, k_prompt, v_prompt, conv_prompt, k_sample, v_sample, conv_sample)
```

```cpp
#include <hip/hip_runtime.h>
#include <hip/hip_cooperative_groups.h>
#include <cstdio>
#include <cstdint>
#include <cmath>
namespace cg = cooperative_groups;
namespace pg8 {
#define PG8_LAS __attribute__((address_space(3)))
typedef unsigned short bf16_t;
typedef short bf16x8 __attribute__((ext_vector_type(8)));
typedef float f32x4 __attribute__((ext_vector_type(4)));
typedef unsigned u32x4 __attribute__((ext_vector_type(4)));
constexpr int BM = 256, BK = 64, HALF = 128, HTB = HALF * BK * 2  , STAGE_BYTES = 8 * HTB, NXCD = 8, WGM = 8;

__host__ __device__ __forceinline__ int lds_byte(int r, int c) { const int st = (r >> 4) * 2 + (c >> 5), rr = r & 15, cc = c & 31, ob = rr * 64 + cc * 2; return st * 1024 + (ob ^ (((ob >> 9) & 1) << 5)); }
__host__ __device__ __forceinline__ void stage_rc(int b, int& R, int& C) { const int st = b / 1024, sb = b % 1024, swz = sb ^ (((sb >> 9) & 1) << 5); R = (st >> 1) * 16 + swz / 64; C = (st & 1) * 32 + (swz % 64) / 2; }
__host__ __device__ __forceinline__ int perm32(int rho) { const int n = rho >> 4, i = rho & 15; return 8 * (i >> 2) + 4 * n + (i & 3); }

struct Unit { int pm, pn, kt0, ks; };
struct Gemm { const bf16_t* A; const bf16_t* Bt; int M, N, K, nt; };

struct StaticOrder {
    int nM, nN, nwg, G, c;
    __host__ __device__ void init(int M, int N, int G_, int c_) { nM = M / BM; nN = N / BM; nwg = nM * nN; G = G_; c = c_; }
    __host__ __device__ bool next(int i, Unit& u) const {
        const long L = (long)i * G + c; if (L >= nwg) return false;
        int wgid = (int)L; { const int q = nwg / NXCD, r = nwg % NXCD, xcd = wgid % NXCD, off = wgid / NXCD; wgid = (xcd < r ? xcd * (q + 1) : r * (q + 1) + (xcd - r) * q) + off; }
        const int nig = WGM * nN, gid = wgid / nig, fm = gid * WGM, gsz = (nM - fm) < WGM ? (nM - fm) : WGM;
        u.pm = fm + ((wgid % nig) % gsz); u.pn = (wgid % nig) / gsz; u.kt0 = 0; u.ks = 0; return true;
    }
    __device__ __forceinline__ void a_ready(const Unit&) const {}
    __device__ __forceinline__ void done(const Unit&) const {}
};

typedef unsigned u32x2 __attribute__((ext_vector_type(2)));
typedef float f32x2_t __attribute__((ext_vector_type(2)));
typedef __bf16 bf16x2_t __attribute__((ext_vector_type(2)));
__device__ __forceinline__ unsigned cvtpk(float lo, float hi) { f32x2_t v = {lo, hi}; bf16x2_t b = __builtin_convertvector(v, bf16x2_t); return __builtin_bit_cast(unsigned, b); }
__device__ __forceinline__ u32x2 pack4(f32x4 v) { u32x2 w; w.x = cvtpk(v[0], v[1]); w.y = cvtpk(v[2], v[3]); return w; }
__device__ __forceinline__ float silu1(float g) { return g * __builtin_amdgcn_rcpf(1.0f + __builtin_amdgcn_exp2f(-1.4426950408889634f * g)); }
__device__ __forceinline__ f32x4 silu_mul(f32x4 g, f32x4 u) { f32x4 o; o[0] = silu1(g[0]) * u[0]; o[1] = silu1(g[1]) * u[1]; o[2] = silu1(g[2]) * u[2]; o[3] = silu1(g[3]) * u[3]; return o; }

__device__ __forceinline__ int opaque_lane() { int l; asm volatile("v_mbcnt_lo_u32_b32 %0, -1, 0\n\tv_mbcnt_hi_u32_b32 %0, -1, %0" : "=v"(l)); return l; }
constexpr int E_MP = 16384;
constexpr int E_DM = 2048;
constexpr float E_EPS = 1e-6f;

struct EpiSwiGLU {
    static constexpr bool PERM = true, AFTER_DRAIN = false;
    bf16_t* H; int ldh; const float* ssq;
    __device__ __forceinline__ void operator()(const f32x4 (&acc)[2][2][4][2], const Unit& u, int wr, int wc, int fr, int fq) const {
        const int row0 = u.pm * BM + wr * 64 + fr; const int col0 = u.pn * HALF + wc * 32 + 8 * fq;
#pragma unroll
        for (int ai = 0; ai < 2; ++ai)
#pragma unroll
            for (int m = 0; m < 4; ++m) { const int row = row0 + ai * HALF + m * 16;
                float rs = 1.f; if (ssq) rs = __builtin_amdgcn_rsqf(ssq[row] * (1.0f / E_DM) + E_EPS);
                const f32x4 h0 = silu_mul(acc[ai][0][m][0] * rs, acc[ai][1][m][0] * rs), h1 = silu_mul(acc[ai][0][m][1] * rs, acc[ai][1][m][1] * rs);
                u32x4 w; w.x = cvtpk(h0[0], h0[1]); w.y = cvtpk(h0[2], h0[3]); w.z = cvtpk(h1[0], h1[1]); w.w = cvtpk(h1[2], h1[3]);
                *(u32x4*)(H + (size_t)row * ldh + col0) = w; }
    }
};

struct EpiResid {
    static constexpr bool PERM = false, AFTER_DRAIN = false;
    const float* base0; const float* base1; float* out; bf16_t* xb; float* ssq; float scale;
    __device__ __forceinline__ void operator()(const f32x4 (&acc)[2][2][4][2], const Unit& u, int wr, int wc, int fr, int fq) const {
        const int row0 = u.pm * BM + wr * 64 + fr; const int col0 = u.pn * BM + wc * 32 + 4 * fq;
#pragma unroll
        for (int ai = 0; ai < 2; ++ai)
#pragma unroll
            for (int m = 0; m < 4; ++m) { const int row = row0 + ai * HALF + m * 16;
                const float* bp = (row < E_MP) ? base0 + (size_t)row * E_DM : base1 + (size_t)(row - E_MP) * E_DM;
                float* op = out + (size_t)row * E_DM; float q = 0.f;
#pragma unroll
                for (int bj = 0; bj < 2; ++bj)
#pragma unroll
                    for (int n = 0; n < 2; ++n) { const int c = col0 + bj * HALF + n * 16; const f32x4 b = *(const f32x4*)(bp + c); const f32x4 o = b + acc[ai][bj][m][n] * scale;
                        *(f32x4*)(op + c) = o; if (xb) *(u32x2*)(xb + (size_t)row * E_DM + c) = pack4(o);
                        q += (o[0] * o[0] + o[1] * o[1]) + (o[2] * o[2] + o[3] * o[3]); }
                if (ssq) { q += __shfl_xor(q, 16); q += __shfl_xor(q, 32); if (fq == 0) atomicAdd(ssq + row, q); }
                asm volatile("" ::: "memory"); }
    }
};

struct EpiProj {
    static constexpr bool PERM = false, AFTER_DRAIN = false;
    const float* ssq; const float* cosT; const float* sinT;
    bf16_t* Q; bf16_t* Kp; bf16_t* Vp; bf16_t* Ks; bf16_t* Vs; bf16_t* CB; bf16_t* U;
    float* kout_p; float* vout_p; float* kout_s; float* vout_s; float* conv_p; float* conv_s;
    __device__ __forceinline__ void operator()(const f32x4 (&acc)[2][2][4][2], const Unit& u, int wr, int wc, int fr, int fq) const {
        const int row0 = u.pm * BM + wr * 64 + fr; const int pn = u.pn;
        constexpr float C2 = 0.125f * 1.4426950408889634f;
#pragma unroll
        for (int ai = 0; ai < 2; ++ai)
#pragma unroll
            for (int m = 0; m < 4; ++m) { const int row = row0 + ai * HALF + m * 16;
                const float rs = __builtin_amdgcn_rsqf(ssq[row] * (1.0f / E_DM) + E_EPS);
                const bool samp = row >= E_MP; const int rsx = row - E_MP;
                const int pos = samp ? 2048 + (rsx & 63) : (row & 4095);
                const size_t kvrow = samp ? (size_t)((rsx >> 6) * 2112 + 2048 + (rsx & 63)) : (size_t)row;
                if (pn < 8) {
                    const int i0 = 16 * (wc & 1) + 4 * fq; const int mp = wc >> 1;
                    const f32x4 c4 = *(const f32x4*)(cosT + pos * 32 + i0), s4 = *(const f32x4*)(sinT + pos * 32 + i0);
#pragma unroll
                    for (int bj = 0; bj < 2; ++bj) { const int head = 2 * (pn & 3) + bj; const int col = head * 128 + mp * 64 + i0;
                        const f32x4 x1 = acc[ai][bj][m][0] * rs, x2 = acc[ai][bj][m][1] * rs;
                        f32x4 y1 = x1 * c4 - x2 * s4, y2 = x2 * c4 + x1 * s4;
                        if (pn < 4) { y1 = y1 * C2; y2 = y2 * C2; bf16_t* qp = Q + (size_t)row * 1024 + col; *(u32x2*)qp = pack4(y1); *(u32x2*)(qp + 32) = pack4(y2); }
                        else { float* ko = (samp ? kout_s + (size_t)rsx * 1024 : kout_p + (size_t)row * 1024) + col; __builtin_nontemporal_store(y1, (f32x4*)ko); __builtin_nontemporal_store(y2, (f32x4*)(ko + 32));
                               bf16_t* kb = (samp ? Ks : Kp) + kvrow * 1024 + col; *(u32x2*)kb = pack4(y1); *(u32x2*)(kb + 32) = pack4(y2); } }
                } else if (pn < 12) {
#pragma unroll
                    for (int bj = 0; bj < 2; ++bj)
#pragma unroll
                        for (int n = 0; n < 2; ++n) { const int col = (pn - 8) * BM + bj * HALF + wc * 32 + n * 16 + 4 * fq; const f32x4 v = acc[ai][bj][m][n] * rs;
                            float* vo = (samp ? vout_s + (size_t)rsx * 1024 : vout_p + (size_t)row * 1024) + col; __builtin_nontemporal_store(v, (f32x4*)vo);
                            *(u32x2*)((samp ? Vs : Vp) + kvrow * 1024 + col) = pack4(v); }
                } else if (pn < 16) {
#pragma unroll
                    for (int bj = 0; bj < 2; ++bj)
#pragma unroll
                        for (int n = 0; n < 2; ++n) { const int col = (pn - 12) * BM + bj * HALF + wc * 32 + n * 16 + 4 * fq; *(u32x2*)(CB + (size_t)row * 1024 + col) = pack4(acc[ai][bj][m][n] * rs); }
                } else {
                    const int t = samp ? (rsx & 63) : (row & 4095); const int tl = samp ? 62 : 4094;
#pragma unroll
                    for (int n = 0; n < 2; ++n) { const int col = (pn - 16) * HALF + wc * 32 + n * 16 + 4 * fq; const f32x4 uu = (acc[ai][0][m][n] * rs) * (acc[ai][1][m][n] * rs);
                        *(u32x2*)(U + (size_t)row * 1024 + col) = pack4(uu);
                        if (t >= tl) { float* cp = samp ? conv_s + (size_t)((rsx >> 6) * 2 + (t - tl)) * 1024 : conv_p + (size_t)((row >> 12) * 2 + (t - tl)) * 1024; *(f32x4*)(cp + col) = uu; } }
                }
                asm volatile("" ::: "memory"); }
    }
};


struct SplitOrder {
    int S, nt, c;
    __host__ __device__ void init(int S_, int nt_, int c_) { S = S_; nt = nt_; c = c_; }
    __host__ __device__ bool next(int i, Unit& u) const {
        if (i != 0) return false;
        const int xcd = c & 7, slot = c >> 3, per = (4 * S) >> 3, cl = slot >> 3;
        if (cl >= per) return false;
        const int combo = xcd * per + cl; u.pm = 64 + combo / S; u.ks = combo % S; u.kt0 = u.ks * nt; u.pn = slot & 7; return true;
    }
    __device__ __forceinline__ void a_ready(const Unit&) const {}
    __device__ __forceinline__ void done(const Unit&) const {}
};
struct EpiPartial {
    static constexpr bool PERM = false, AFTER_DRAIN = false;
    float* part;
    __device__ __forceinline__ void operator()(const f32x4 (&acc)[2][2][4][2], const Unit& u, int wr, int wc, int fr, int fq) const {
        const int row0 = (u.pm - 64) * BM + wr * 64 + fr; const int col0 = u.pn * BM + wc * 32 + 4 * fq;
        float* pb = part + (size_t)u.ks * 1024 * E_DM;
#pragma unroll
        for (int ai = 0; ai < 2; ++ai)
#pragma unroll
            for (int m = 0; m < 4; ++m) { float* op = pb + (size_t)(row0 + ai * HALF + m * 16) * E_DM + col0;
#pragma unroll
                for (int bj = 0; bj < 2; ++bj)
#pragma unroll
                    for (int n = 0; n < 2; ++n) *(f32x4*)(op + bj * HALF + n * 16) = acc[ai][bj][m][n]; }
    }
};
template <class Epi, class Sched, bool ALIGN_EPI = false, bool SP2 = false>
__device__ __forceinline__ void gemm_phase(PG8_LAS unsigned char* lds, const Gemm g, const Sched& S, const Epi& E, const int wid_in) {
    const int wid = wid_in, lane = opaque_lane(), tid = wid * 64 + lane, wr = wid >> 2, wc = wid & 3, fr = lane & 15, fq = lane >> 4;
    const int K = g.K, nt = g.nt;
    unsigned voffA[2], voffB[2];
#pragma unroll
    for (int i = 0; i < 2; ++i) { int R, C; stage_rc(tid * 16 + i * 8192, R, C); const int Rb = Epi::PERM ? ((R & ~31) + perm32(R & 31)) : R;
        voffA[i] = (unsigned)(R * K + C) * 2u; voffB[i] = (unsigned)(Rb * K + C) * 2u; }
    const size_t kstep = (size_t)(BK * 2);
    const size_t hstep = (size_t)HALF * K * 2;
    const size_t tstep = 2 * hstep;
    const unsigned ldsw = (unsigned)wid * 1024u;
    const int aoff = lds_byte(wr * 64 + fr, fq * 8), boff = lds_byte(wc * 32 + fr, fq * 8);
#define PG8_SA(b, h) (((b) * 2 + (h)) * HTB)
#define PG8_SB(b, h) ((4 + (b) * 2 + (h)) * HTB)
#define PG8_STAGE(bufoff, gbase, voff) do { _Pragma("unroll") for (int _i = 0; _i < 2; ++_i) \
        __builtin_amdgcn_global_load_lds((const unsigned*)((const char*)(gbase) + (voff)[_i]), (PG8_LAS unsigned*)(lds + (bufoff) + ldsw + _i * 8192), 16, 0, 0); } while (0)
#define PG8_LDA(dst, b, h) do { _Pragma("unroll") for (int m = 0; m < 4; ++m) _Pragma("unroll") for (int k = 0; k < 2; ++k) dst[m][k] = *(const PG8_LAS bf16x8*)(lds + PG8_SA(b, h) + aoff + m * 2048 + k * 1024); } while (0)
#define PG8_LDB(dst, b, h) do { _Pragma("unroll") for (int n = 0; n < 2; ++n) _Pragma("unroll") for (int k = 0; k < 2; ++k) dst[n][k] = *(const PG8_LAS bf16x8*)(lds + PG8_SB(b, h) + boff + n * 2048 + k * 1024); } while (0)
#define PG8_MMA(ai, bj, At, Bt) do { __builtin_amdgcn_s_setprio(1); _Pragma("unroll") for (int m = 0; m < 4; ++m) _Pragma("unroll") for (int n = 0; n < 2; ++n) _Pragma("unroll") for (int k = 0; k < 2; ++k) \
        acc[ai][bj][m][n] = __builtin_amdgcn_mfma_f32_16x16x32_bf16(Bt[n][k], At[m][k], acc[ai][bj][m][n], 0, 0, 0); __builtin_amdgcn_s_setprio(0); } while (0)
#define PG8_WAIT_V(n) asm volatile("s_waitcnt vmcnt(" #n ")" ::: "memory")
#define PG8_WAIT_L(n) asm volatile("s_waitcnt lgkmcnt(" #n ")" ::: "memory")
#define PG8_BAR __builtin_amdgcn_s_barrier()
#define PG8_SCHED __builtin_amdgcn_sched_barrier(0)
    Unit cur, nxt; int ui = 0;
    if (!S.next(0, cur)) return;
    f32x4 acc[2][2][4][2];
#pragma unroll
    for (int a = 0; a < 2; ++a)
#pragma unroll
        for (int b = 0; b < 2; ++b)
#pragma unroll
            for (int m = 0; m < 4; ++m)
#pragma unroll
                for (int n = 0; n < 2; ++n) acc[a][b][m][n] = (f32x4){0.f, 0.f, 0.f, 0.f};
    bf16x8 At[4][2], B0[2][2], B1[2][2];
    const char* cA = (const char*)g.A + (size_t)cur.pm * tstep + (size_t)cur.kt0 * kstep; const char* cB = (const char*)g.Bt + (size_t)cur.pn * tstep + (size_t)cur.kt0 * kstep;
    S.a_ready(cur);
    if constexpr (SP2) {
        PG8_STAGE(PG8_SB(0, 0), cB, voffB); PG8_STAGE(PG8_SB(0, 1), cB + hstep, voffB); PG8_STAGE(PG8_SA(0, 0), cA, voffA); PG8_STAGE(PG8_SA(0, 1), cA + hstep, voffA);
        if (wr == 1) PG8_BAR;
        PG8_WAIT_V(2); PG8_BAR;
        PG8_STAGE(PG8_SB(1, 0), cB + kstep, voffB); PG8_STAGE(PG8_SA(1, 0), cA + kstep, voffA); PG8_STAGE(PG8_SB(1, 1), cB + hstep + kstep, voffB);
        PG8_WAIT_V(6); PG8_BAR;
    } else {
        PG8_STAGE(PG8_SB(0, 0), cB, voffB); PG8_STAGE(PG8_SA(0, 0), cA, voffA); PG8_STAGE(PG8_SB(0, 1), cB + hstep, voffB); PG8_STAGE(PG8_SA(0, 1), cA + hstep, voffA);
        if (wr == 1) PG8_BAR;
        PG8_WAIT_V(4); PG8_BAR;
        PG8_STAGE(PG8_SB(1, 0), cB + kstep, voffB); PG8_STAGE(PG8_SA(1, 0), cA + kstep, voffA); PG8_STAGE(PG8_SB(1, 1), cB + hstep + kstep, voffB);
        PG8_WAIT_V(6); PG8_BAR;
    }
    for (;;) {
        const bool has_next = S.next(ui + 1, nxt);
        const char* nA = has_next ? (const char*)g.A + (size_t)nxt.pm * tstep + (size_t)nxt.kt0 * kstep : cA; const char* nB = has_next ? (const char*)g.Bt + (size_t)nxt.pn * tstep + (size_t)nxt.kt0 * kstep : cB;
        for (int t = 0; t < nt; t += 2) {
            const bool last = (t == nt - 2);
            const char* a1 = cA + (size_t)(t + 1) * kstep;
            const char* a2 = last ? nA : cA + (size_t)(t + 2) * kstep; const char* b2 = last ? nB : cB + (size_t)(t + 2) * kstep;
            const char* a3 = a2 + kstep; const char* b3 = b2 + kstep;
            if (last && has_next) S.a_ready(nxt);
            if constexpr (SP2) {
            PG8_LDB(B0, 0, 0); PG8_LDB(B1, 0, 1); PG8_SCHED; PG8_LDA(At, 0, 0); PG8_STAGE(PG8_SA(1, 1), a1 + hstep, voffA);
            PG8_WAIT_V(8); PG8_WAIT_L(0); PG8_BAR; PG8_MMA(0, 0, At, B0); PG8_MMA(0, 1, At, B1); PG8_BAR; PG8_SCHED;
            PG8_LDA(At, 0, 1); PG8_STAGE(PG8_SB(0, 0), b2, voffB); PG8_STAGE(PG8_SB(0, 1), b2 + hstep, voffB); PG8_STAGE(PG8_SA(0, 0), a2, voffA);
            PG8_WAIT_V(8); PG8_WAIT_L(0); PG8_BAR; PG8_MMA(1, 0, At, B0); PG8_MMA(1, 1, At, B1); PG8_BAR; PG8_SCHED;
            PG8_LDB(B0, 1, 0); PG8_LDB(B1, 1, 1); PG8_SCHED; PG8_LDA(At, 1, 0); PG8_STAGE(PG8_SA(0, 1), a2 + hstep, voffA);
            PG8_WAIT_V(8); PG8_WAIT_L(0); PG8_BAR; PG8_MMA(0, 0, At, B0); PG8_MMA(0, 1, At, B1); PG8_BAR; PG8_SCHED;
            PG8_LDA(At, 1, 1); PG8_STAGE(PG8_SB(1, 0), b3, voffB); PG8_STAGE(PG8_SB(1, 1), b3 + hstep, voffB); PG8_STAGE(PG8_SA(1, 0), a3, voffA);
            PG8_WAIT_V(8); PG8_WAIT_L(0); PG8_BAR; PG8_MMA(1, 0, At, B0); PG8_MMA(1, 1, At, B1); PG8_BAR; PG8_SCHED;
            } else {
            PG8_LDB(B0, 0, 0); PG8_SCHED; PG8_LDA(At, 0, 0); PG8_STAGE(PG8_SA(1, 1), a1 + hstep, voffA);
            PG8_WAIT_L(8); PG8_BAR; PG8_WAIT_L(0); PG8_MMA(0, 0, At, B0); PG8_BAR; PG8_SCHED;
            PG8_LDB(B1, 0, 1); PG8_STAGE(PG8_SB(0, 0), b2, voffB);
            PG8_BAR; PG8_WAIT_L(0); PG8_MMA(0, 1, At, B1); PG8_BAR;
            PG8_LDA(At, 0, 1); PG8_STAGE(PG8_SA(0, 0), a2, voffA);
            PG8_BAR; PG8_WAIT_L(0); PG8_MMA(1, 0, At, B0); PG8_BAR; PG8_SCHED;
            PG8_STAGE(PG8_SB(0, 1), b2 + hstep, voffB);
            PG8_WAIT_V(6); PG8_BAR; PG8_MMA(1, 1, At, B1); PG8_BAR;
            PG8_LDB(B0, 1, 0); PG8_SCHED; PG8_LDA(At, 1, 0); PG8_STAGE(PG8_SA(0, 1), a2 + hstep, voffA);
            PG8_WAIT_L(8); PG8_BAR; PG8_WAIT_L(0); PG8_MMA(0, 0, At, B0); PG8_BAR; PG8_SCHED;
            PG8_LDB(B1, 1, 1); PG8_STAGE(PG8_SB(1, 0), b3, voffB);
            PG8_BAR; PG8_WAIT_L(0); PG8_MMA(0, 1, At, B1); PG8_BAR;
            PG8_LDA(At, 1, 1); PG8_STAGE(PG8_SA(1, 0), a3, voffA);
            PG8_BAR; PG8_WAIT_L(0); PG8_MMA(1, 0, At, B0); PG8_BAR; PG8_SCHED;
            PG8_STAGE(PG8_SB(1, 1), b3 + hstep, voffB);
            PG8_WAIT_V(6); PG8_BAR; PG8_MMA(1, 1, At, B1); PG8_BAR;
            }
        }
        if constexpr (ALIGN_EPI) { if (wr == 0) PG8_BAR; }
        if constexpr (!Epi::AFTER_DRAIN) { E(acc, cur, wr, wc, fr, fq); S.done(cur); }
        if (!has_next) break;
#pragma unroll
        for (int a = 0; a < 2; ++a)
#pragma unroll
            for (int b = 0; b < 2; ++b)
#pragma unroll
                for (int m = 0; m < 4; ++m)
#pragma unroll
                    for (int n = 0; n < 2; ++n) acc[a][b][m][n] = (f32x4){0.f, 0.f, 0.f, 0.f};
        cur = nxt; cA = nA; cB = nB; ++ui;
        if constexpr (ALIGN_EPI) { if (wr == 1) PG8_BAR; }
    }
    PG8_WAIT_V(0);
    if constexpr (!ALIGN_EPI) { if (wr == 0) PG8_BAR; }
    PG8_BAR;
    if constexpr (Epi::AFTER_DRAIN) { E.fused(acc, cur, wr, wc, fr, fq, lds, wid, lane); S.done(cur); }
#undef PG8_SA
#undef PG8_SB
#undef PG8_STAGE
#undef PG8_LDA
#undef PG8_LDB
#undef PG8_MMA
#undef PG8_WAIT_V
#undef PG8_WAIT_L
#undef PG8_BAR
#undef PG8_SCHED
}
}

#define LAS __attribute__((address_space(3)))
typedef unsigned short bf16_t;
typedef short bf16x8 __attribute__((ext_vector_type(8)));
typedef short s16x4 __attribute__((ext_vector_type(4)));
typedef float f32x4 __attribute__((ext_vector_type(4)));
typedef float f32x16 __attribute__((ext_vector_type(16)));
typedef unsigned u32x4 __attribute__((ext_vector_type(4)));
typedef unsigned u32x2 __attribute__((ext_vector_type(2)));
using pg8::cvtpk;

constexpr int NWAVES = 8, NTHREADS = 512;
constexpr int D_MODEL = 2048, FFN = 5632, PROJ = 6144;
constexpr int MP = 16384, MS = 1024, MROWS = MP + MS;
constexpr int SEQ = 4096, DSEQ = 64, PAST = 2048, SKV = PAST + DSEQ;
constexpr float EPS = 1e-6f;
constexpr float LAMBDA_INIT = 0.2f;

constexpr size_t MiB = 1u << 20;
constexpr size_t WS_CTL = 0;
constexpr size_t WS_ROPE = 1 * MiB;
constexpr size_t WS_W1GU = 2 * MiB, WS_W1D = 46 * MiB, WS_WIN = 68 * MiB, WS_WOUT = 92 * MiB, WS_W2GU = 100 * MiB, WS_W2D = 144 * MiB;
constexpr size_t WS_XB = 166 * MiB;
constexpr size_t WS_H = 234 * MiB;
constexpr size_t WS_Q = 234 * MiB, WS_U = 268 * MiB, WS_CB = 302 * MiB, WS_A2 = 336 * MiB;
constexpr size_t WS_KP = 421 * MiB, WS_VP = 453 * MiB, WS_KS = 485 * MiB, WS_VS = 551 * MiB, WS_PART = 617 * MiB, WS_END = 681 * MiB;
static_assert(WS_A2 + (size_t)MROWS * 2048 * 2 <= WS_KP && WS_H + (size_t)MROWS * FFN * 2 <= WS_KP, "ws map");

constexpr size_t O_Y = 0, O_KP = 35651584, O_VP = 52428800, O_CP = 69206016, O_KS = 69214208, O_VS = 70262784, O_CS = 71311360, O_END = 71344128;

constexpr int RING_BYTES = 147456, LDS_BYTES = RING_BYTES + 1024;
constexpr int CW_BAR = 131072;
constexpr int XCD_BAR_WORDS_C = 3456;

struct Params { const float* in[23]; float* out; unsigned char* ws; };

__device__ __forceinline__ float wave_sum(float v) {
#pragma unroll
    for (int o = 1; o < 64; o <<= 1) v += __shfl_xor(v, o);
    return v;
}

__device__ __forceinline__ void transpose_item(const float* W, int ldw, int coff, int K, const float* gain, bf16_t* WT, int dbase, int hstride, int dadd, bool swp,
                                               LAS float* scr, int kb, int nb, int lane) {
    const int k0 = 64 * kb, n0 = 32 * nb;
    { f32x4 w[8]; const int c4 = 4 * (lane & 7);
#pragma unroll
      for (int i = 0; i < 8; ++i) w[i] = __builtin_nontemporal_load((const f32x4*)(W + (size_t)(k0 + 8 * i + (lane >> 3)) * ldw + coff + n0 + c4));
#pragma unroll
      for (int i = 0; i < 8; ++i) { const int kk = 8 * i + (lane >> 3); const float gg = gain ? gain[k0 + kk] : 1.0f; LAS float* d = scr + kk * 33 + c4;
          d[0] = w[i][0] * gg; d[1] = w[i][1] * gg; d[2] = w[i][2] * gg; d[3] = w[i][3] * gg; } }
    asm volatile("s_waitcnt lgkmcnt(0)" ::: "memory");
    const int c = lane & 7;
#pragma unroll
    for (int j = 0; j < 4; ++j) { const int n = (lane >> 3) + 8 * j; const LAS float* s = scr + (8 * c) * 33 + n;
        u32x4 o; o.x = cvtpk(s[0 * 33], s[1 * 33]); o.y = cvtpk(s[2 * 33], s[3 * 33]); o.z = cvtpk(s[4 * 33], s[5 * 33]); o.w = cvtpk(s[6 * 33], s[7 * 33]);
        const int col = n0 + n; int low = col & 127; if (swp) low = (low & ~48) | ((low & 16) << 1) | ((low & 32) >> 1);
        const int drow = dbase + (col >> 7) * hstride + dadd + low;
        *(u32x4*)(WT + (size_t)drow * K + k0 + 8 * c) = o; }
    asm volatile("s_waitcnt lgkmcnt(0)" ::: "memory");
}

__device__ __forceinline__ void prologue(const Params& P, LAS unsigned char* lds, const int wid_in) {
    const int wave = wid_in, lane = pg8::opaque_lane(), tid = wave * 64 + lane;
    const int gw = blockIdx.x * NWAVES + wave, NGW = gridDim.x * NWAVES;
    const int gt = blockIdx.x * NTHREADS + tid, NGT = gridDim.x * NTHREADS;
    unsigned char* ws = P.ws;
    { unsigned* ctl = (unsigned*)(ws + WS_CTL); if (gt < 9) ctl[64 * gt] = 0u; if (gt < 64) ctl[65536 + 16 * gt] = 0u; for (int i = gt; i < XCD_BAR_WORDS_C; i += NGT) ctl[CW_BAR + i] = 0u; float* ssq = (float*)(ws + WS_CTL + 4096); for (int i = gt; i < 3 * MROWS; i += NGT) ssq[i] = 0.f; }
    { float* cosT = (float*)(ws + WS_ROPE); float* sinT = cosT + 4096 * 32;
      for (int e = gt; e < 4096 * 32; e += NGT) { const int pos = e >> 5, i = e & 31;
          const float inv = exp2f(-(float)i * 0.41524101186092029f);
          const float ang = (float)pos * inv;
          double r = (double)ang; r -= 6.283185307179586477 * rint(r * 0.15915494309189533577);
          const double r2 = r * r;
          double s = -1.0 / 25852016738884976640000.0;
          s = s * r2 + 1.0 / 51090942171709440000.0;
          s = s * r2 - 1.0 / 121645100408832000.0;
          s = s * r2 + 1.0 / 355687428096000.0;
          s = s * r2 - 1.0 / 1307674368000.0;
          s = s * r2 + 1.0 / 6227020800.0;
          s = s * r2 - 1.0 / 39916800.0;
          s = s * r2 + 1.0 / 362880.0;
          s = s * r2 - 1.0 / 5040.0;
          s = s * r2 + 1.0 / 120.0;
          s = s * r2 - 1.0 / 6.0;
          s = s * r2 + 1.0; s *= r;
          double c = 1.0 / 1124000727777607680000.0;
          c = c * r2 - 1.0 / 2432902008176640000.0;
          c = c * r2 + 1.0 / 6402373705728000.0;
          c = c * r2 - 1.0 / 20922789888000.0;
          c = c * r2 + 1.0 / 87178291200.0;
          c = c * r2 - 1.0 / 479001600.0;
          c = c * r2 + 1.0 / 3628800.0;
          c = c * r2 - 1.0 / 40320.0;
          c = c * r2 + 1.0 / 720.0;
          c = c * r2 - 1.0 / 24.0;
          c = c * r2 + 0.5; c = 1.0 - c * r2;
          cosT[e] = (float)c; sinT[e] = (float)s; } }
    { LAS float* scr = (LAS float*)(lds + wave * 16384);
      constexpr int I_GU = (D_MODEL / 64) * (FFN / 32), I_D = (FFN / 64) * (D_MODEL / 32), I_S = (D_MODEL / 64) * (1024 / 32), I_O = (D_MODEL / 64) * (D_MODEL / 32);
      constexpr int NITEMS = 4 * I_GU + 2 * I_D + 6 * I_S + I_O;
      bf16_t* W1GU = (bf16_t*)(ws + WS_W1GU); bf16_t* W1D = (bf16_t*)(ws + WS_W1D); bf16_t* WIN = (bf16_t*)(ws + WS_WIN); bf16_t* WOUT = (bf16_t*)(ws + WS_WOUT);
      bf16_t* W2GU = (bf16_t*)(ws + WS_W2GU); bf16_t* W2D = (bf16_t*)(ws + WS_W2D);
      for (int it = gw; it < NITEMS; it += NGW) { int r = it;
          if (r < I_GU) { transpose_item(P.in[6], FFN, 0, D_MODEL, P.in[5], W1GU, 0, 256, 0, false, scr, r / (FFN / 32), r % (FFN / 32), lane); continue; } r -= I_GU;
          if (r < I_GU) { transpose_item(P.in[7], FFN, 0, D_MODEL, P.in[5], W1GU, 0, 256, 128, false, scr, r / (FFN / 32), r % (FFN / 32), lane); continue; } r -= I_GU;
          if (r < I_GU) { transpose_item(P.in[19], FFN, 0, D_MODEL, P.in[18], W2GU, 0, 256, 0, false, scr, r / (FFN / 32), r % (FFN / 32), lane); continue; } r -= I_GU;
          if (r < I_GU) { transpose_item(P.in[20], FFN, 0, D_MODEL, P.in[18], W2GU, 0, 256, 128, false, scr, r / (FFN / 32), r % (FFN / 32), lane); continue; } r -= I_GU;
          if (r < I_D) { transpose_item(P.in[8], D_MODEL, 0, FFN, nullptr, W1D, 0, 128, 0, false, scr, r / (D_MODEL / 32), r % (D_MODEL / 32), lane); continue; } r -= I_D;
          if (r < I_D) { transpose_item(P.in[21], D_MODEL, 0, FFN, nullptr, W2D, 0, 128, 0, false, scr, r / (D_MODEL / 32), r % (D_MODEL / 32), lane); continue; } r -= I_D;
          if (r < I_S) { transpose_item(P.in[10], PROJ, 0, D_MODEL, P.in[9], WIN, 0, 128, 0, true, scr, r / 32, r % 32, lane); continue; } r -= I_S;
          if (r < I_S) { transpose_item(P.in[10], PROJ, 1024, D_MODEL, P.in[9], WIN, 1024, 128, 0, true, scr, r / 32, r % 32, lane); continue; } r -= I_S;
          if (r < I_S) { transpose_item(P.in[10], PROJ, 2048, D_MODEL, P.in[9], WIN, 2048, 128, 0, false, scr, r / 32, r % 32, lane); continue; } r -= I_S;
          if (r < I_S) { transpose_item(P.in[10], PROJ, 3072, D_MODEL, P.in[9], WIN, 3072, 128, 0, false, scr, r / 32, r % 32, lane); continue; } r -= I_S;
          if (r < I_S) { transpose_item(P.in[10], PROJ, 4096, D_MODEL, P.in[9], WIN, 4096, 256, 0, false, scr, r / 32, r % 32, lane); continue; } r -= I_S;
          if (r < I_S) { transpose_item(P.in[10], PROJ, 5120, D_MODEL, P.in[9], WIN, 4096, 256, 128, false, scr, r / 32, r % 32, lane); continue; } r -= I_S;
          transpose_item(P.in[17], D_MODEL, 0, D_MODEL, nullptr, WOUT, 0, 128, 0, false, scr, r / (D_MODEL / 32), r % (D_MODEL / 32), lane);
      } }
    { bf16_t* XB = (bf16_t*)(ws + WS_XB);
      for (int m = gw; m < MROWS; m += NGW) { const float* xr = (m < MP) ? P.in[0] + (size_t)m * D_MODEL : P.in[1] + (size_t)(m - MP) * D_MODEL;
          f32x4 v[8]; float s = 0.f;
#pragma unroll
          for (int j = 0; j < 8; ++j) { v[j] = __builtin_nontemporal_load((const f32x4*)(xr + 256 * j + 4 * lane)); s += (v[j][0] * v[j][0] + v[j][1] * v[j][1]) + (v[j][2] * v[j][2] + v[j][3] * v[j][3]); }
          const float rs = __builtin_amdgcn_rsqf(wave_sum(s) * (1.0f / D_MODEL) + EPS);
#pragma unroll
          for (int j = 0; j < 8; ++j) *(u32x2*)(XB + (size_t)m * D_MODEL + 256 * j + 4 * lane) = pg8::pack4(v[j] * rs); } }
}

constexpr int CV_BLOCKS = 2 * 16 * PAST * 1024 / 32768;
__device__ __forceinline__ void cache_convert_blocks(const Params& P, LAS unsigned char* lds, const int wid_in, int max_blocks) {
    const int lane = pg8::opaque_lane(), tid = wid_in * 64 + lane;
    unsigned* counter = (unsigned*)(P.ws + WS_CTL) + 64 * 8;
    LAS unsigned* slot = (LAS unsigned*)(lds + RING_BYTES + 8);
    bf16_t* KS = (bf16_t*)(P.ws + WS_KS); bf16_t* VS = (bf16_t*)(P.ws + WS_VS);
    for (int n = 0; n < max_blocks; ++n) {
        __syncthreads();
        if (tid == 0) *slot = atomicAdd(counter, 1u);
        __syncthreads();
        const int blk = (int)*slot;
        if (blk >= CV_BLOCKS) break;
        const int which = blk >= CV_BLOCKS / 2; const size_t el0 = (size_t)(which ? blk - CV_BLOCKS / 2 : blk) * 32768;
        const float* src = (which ? P.in[3] : P.in[2]) + el0; bf16_t* dst = which ? VS : KS;
#pragma unroll
        for (int half = 0; half < 2; ++half) { f32x4 a[4], c[4];
#pragma unroll
            for (int k = 0; k < 4; ++k) { const float* sp = src + (size_t)((half * 4 + k) * NTHREADS + tid) * 8; a[k] = __builtin_nontemporal_load((const f32x4*)sp); c[k] = __builtin_nontemporal_load((const f32x4*)(sp + 4)); }
#pragma unroll
            for (int k = 0; k < 4; ++k) { const size_t el = el0 + (size_t)((half * 4 + k) * NTHREADS + tid) * 8; const int b = (int)(el >> 21); const size_t rem = el & ((1u << 21) - 1);
                u32x4 w; w.x = cvtpk(a[k][0], a[k][1]); w.y = cvtpk(a[k][2], a[k][3]); w.z = cvtpk(c[k][0], c[k][1]); w.w = cvtpk(c[k][2], c[k][3]);
                *(u32x4*)(dst + (size_t)b * SKV * 1024 + rem) = w; } }
    }
}

__device__ __forceinline__ void bf8_to_f32(u32x4 w, float (&f)[8]) {
#pragma unroll
    for (int i = 0; i < 4; ++i) { f[2 * i] = __uint_as_float(w[i] << 16); f[2 * i + 1] = __uint_as_float(w[i] & 0xffff0000u); }
}
__device__ __forceinline__ void conv_phase(const Params& P, const int wid_in) {
    const int wave = wid_in, lane = pg8::opaque_lane();
    const int gw = blockIdx.x * NWAVES + wave, NGW = gridDim.x * NWAVES;
    const bf16_t* U = (const bf16_t*)(P.ws + WS_U); const bf16_t* CB = (const bf16_t*)(P.ws + WS_CB); bf16_t* A2 = (bf16_t*)(P.ws + WS_A2);
    const float* cw = P.in[16]; const float* st = P.in[4];
    for (int it = gw; it < (MROWS / 8) * 2; it += NGW) { const int row0 = (it >> 1) * 8, c0 = (it & 1) * 512 + lane * 8;
        const bool samp = row0 >= MP; const int rsx0 = row0 - MP; const int t0 = samp ? (rsx0 & 63) : (row0 & 4095); const int b = rsx0 >> 6;
        u32x4 ur[8], cr[8], hr0, hr1; f32x4 sa0, sc0, sa1, sc1;
#pragma unroll
        for (int i = 0; i < 8; ++i) { ur[i] = *(const u32x4*)(U + (size_t)(row0 + i) * 1024 + c0); cr[i] = *(const u32x4*)(CB + (size_t)(row0 + i) * 1024 + c0); }
        float p2[8], p1[8], w0[8], w1[8], w2[8];
        if (t0 > 0) { hr0 = *(const u32x4*)(U + (size_t)(row0 - 2) * 1024 + c0); hr1 = *(const u32x4*)(U + (size_t)(row0 - 1) * 1024 + c0); bf8_to_f32(hr0, p2); bf8_to_f32(hr1, p1); }
        else if (samp) { const float* sp = st + (size_t)(b * 2) * 1024 + c0; sa0 = *(const f32x4*)sp; sc0 = *(const f32x4*)(sp + 4); sa1 = *(const f32x4*)(sp + 1024); sc1 = *(const f32x4*)(sp + 1028);
#pragma unroll
            for (int i = 0; i < 4; ++i) { p2[i] = sa0[i]; p2[4 + i] = sc0[i]; p1[i] = sa1[i]; p1[4 + i] = sc1[i]; } }
        else {
#pragma unroll
            for (int i = 0; i < 8; ++i) { p2[i] = 0.f; p1[i] = 0.f; } }
        { const f32x4 a = *(const f32x4*)(cw + c0), c = *(const f32x4*)(cw + c0 + 4); for (int i = 0; i < 4; ++i) { w0[i] = a[i]; w0[4 + i] = c[i]; } }
        { const f32x4 a = *(const f32x4*)(cw + 1024 + c0), c = *(const f32x4*)(cw + 1024 + c0 + 4); for (int i = 0; i < 4; ++i) { w1[i] = a[i]; w1[4 + i] = c[i]; } }
        { const f32x4 a = *(const f32x4*)(cw + 2048 + c0), c = *(const f32x4*)(cw + 2048 + c0 + 4); for (int i = 0; i < 4; ++i) { w2[i] = a[i]; w2[4 + i] = c[i]; } }
#pragma unroll
        for (int r = 0; r < 8; ++r) { float cur[8], cb[8], o[8]; bf8_to_f32(ur[r], cur); bf8_to_f32(cr[r], cb);
#pragma unroll
            for (int i = 0; i < 8; ++i) { o[i] = cb[i] * (w0[i] * p2[i] + w1[i] * p1[i] + w2[i] * cur[i]); p2[i] = p1[i]; p1[i] = cur[i]; }
            u32x4 w; w.x = cvtpk(o[0], o[1]); w.y = cvtpk(o[2], o[3]); w.z = cvtpk(o[4], o[5]); w.w = cvtpk(o[6], o[7]);
            *(u32x4*)(A2 + (size_t)(row0 + r) * 2048 + 1024 + c0) = w; } }
}

constexpr int NUNITS = 1024 + 64;
__device__ __forceinline__ s16x4 tr16(const LAS unsigned char* p) {
    typedef short v4i16_t __attribute__((ext_vector_type(4)));
    return __builtin_bit_cast(s16x4, __builtin_amdgcn_ds_read_tr16_b64_v4i16((LAS v4i16_t*)p));
}
__device__ __forceinline__ void glds16(const void* gsrc, unsigned lds_dst) { unsigned keep;
    asm volatile("s_mov_b32 %0, m0\n\ts_mov_b32 m0, %2\n\ts_nop 0\n\tglobal_load_lds_dwordx4 %1, off\n\ts_mov_b32 m0, %0" : "=&s"(keep) : "v"(gsrc), "s"(lds_dst) : "memory"); }
__device__ __forceinline__ float max3f(float a, float b, float c) { float r; asm("v_max3_f32 %0, %1, %2, %3" : "=v"(r) : "v"(a), "v"(b), "v"(c)); return r; }
__device__ __forceinline__ void attn_phase(const Params& P, LAS unsigned char* lds, const int wid_in) {
    const int wid = wid_in, lane = pg8::opaque_lane(), tid = wid * 64 + lane;
    const int g = wid >> 2, rg = wid & 3;
    const int l32 = lane & 31, hi = lane >> 5;
    const bf16_t* Q = (const bf16_t*)(P.ws + WS_Q); bf16_t* A2 = (bf16_t*)(P.ws + WS_A2);
    unsigned* counter = (unsigned*)(P.ws + WS_CTL);
    LAS unsigned* qslot = (LAS unsigned*)(lds + RING_BYTES);
    float lam;
    { const float a = P.in[11][lane] * P.in[12][lane], b = P.in[13][lane] * P.in[14][lane]; lam = __expf(wave_sum(a)) - __expf(wave_sum(b)) + LAMBDA_INIT; }
    const int r2 = lane >> 4, pc = lane & 15;
    const unsigned lds0 = (unsigned)(uintptr_t)lds;
    unsigned koffv[2], voffv[2];
#pragma unroll
    for (int i = 0; i < 2; ++i) { const int row = 8 * wid + 4 * i + r2; koffv[i] = (unsigned)(row * 2048 + 16 * (pc ^ (row & 15))); voffv[i] = (unsigned)(row * 2048 + 16 * (pc ^ (((row & 3) << 2) | ((row >> 2) & 3)))); }
    unsigned kro[4];
#pragma unroll
    for (int d0 = 0; d0 < 4; ++d0) { const int ch = 8 * g + 2 * d0 + hi; kro[d0] = (unsigned)(l32 * 256 + 16 * (ch ^ (l32 & 15))); }
    const int i16 = lane & 15, q_ = i16 >> 2, p_ = i16 & 3, gcol = (lane >> 4) & 1;
    unsigned vro[4][2];
#pragma unroll
    for (int blk = 0; blk < 4; ++blk)
#pragma unroll
        for (int sec = 0; sec < 2; ++sec) { const int row = 4 * hi + 8 * sec + q_; const int c = 4 * blk + 2 * gcol + (p_ >> 1); const int swz = ((row & 3) << 2) | ((row >> 2) & 3);
            vro[blk][sec] = (unsigned)(256 * row + 16 * (c ^ swz) + 8 * (p_ & 1)); }
    int myq = (int)(__builtin_amdgcn_s_getreg((3 << 11) | 20) & 7u), tries = 0;
    for (;;) {
        __syncthreads();
        if (tid == 0) *qslot = atomicAdd(counter + 64 * myq, 1u);
        __syncthreads();
        const int ui = (int)*qslot;
        if (ui >= 144) { if (++tries == 8) break; myq = (myq + 1) & 7; continue; }
        int b, head, NT, NTw, qrow0; const bf16_t* Kb; const bf16_t* Vb;
        if (ui >= 60 && ui < 76) { const int s = 16 * myq + (ui - 60); b = s >> 3; head = s & 7; NT = 33; NTw = (rg < 2) ? 33 : 0; qrow0 = MP + 64 * b;
            Kb = (const bf16_t*)(P.ws + WS_KS) + (size_t)b * SKV * 1024; Vb = (const bf16_t*)(P.ws + WS_VS) + (size_t)b * SKV * 1024; }
        else { int cp, pr; if (ui < 60) { cp = 31 - (ui >> 2); pr = 4 * myq + (ui & 3); } else { const int v = ui - 76; cp = 16 - (v >> 2); pr = 4 * myq + (v & 3); }
            b = pr >> 3; head = pr & 7; NT = 2 * cp + 2; NTw = NT - ((rg < 2) ? 1 : 0); qrow0 = b * SEQ + 128 * cp;
            Kb = (const bf16_t*)(P.ws + WS_KP) + (size_t)b * SEQ * 1024; Vb = (const bf16_t*)(P.ws + WS_VP) + (size_t)b * SEQ * 1024; }
        const char* kgb = (const char*)Kb + head * 256; const char* vgb = (const char*)Vb + head * 256;
#define AT_DMA(k) do { const int k_ = (k); const unsigned lk_ = lds0 + (unsigned)((k_ & 3) * 16384 + wid * 2048), lv_ = lds0 + 65536u + (unsigned)((k_ % 5) * 16384 + wid * 2048); const size_t to_ = (size_t)k_ * 131072; _Pragma("unroll") for (int i = 0; i < 2; ++i) { \
            glds16(kgb + to_ + koffv[i], (unsigned)__builtin_amdgcn_readfirstlane(lk_ + i * 1024)); glds16(vgb + to_ + voffv[i], (unsigned)__builtin_amdgcn_readfirstlane(lv_ + i * 1024)); } } while (0)
        AT_DMA(0); AT_DMA(1);
        bf16x8 qf[4];
        { int qrow = qrow0 + 32 * rg + l32; qrow = qrow < MROWS ? qrow : MROWS - 1;
          const bf16_t* qp = Q + (size_t)qrow * 1024 + head * 128 + g * 64 + hi * 8;
#pragma unroll
          for (int d0 = 0; d0 < 4; ++d0) qf[d0] = *(const bf16x8*)(qp + 16 * d0); }
        asm volatile("" : "+v"(qf[0]), "+v"(qf[1]), "+v"(qf[2]), "+v"(qf[3]));
        asm volatile("s_waitcnt vmcnt(0) lgkmcnt(0)" ::: "memory"); __builtin_amdgcn_s_barrier(); asm volatile("" ::: "memory");
        f32x16 o[4];
#pragma unroll
        for (int blk = 0; blk < 4; ++blk)
#pragma unroll
            for (int r = 0; r < 16; ++r) o[blk][r] = 0.f;
        float mref = 0.f, lrun = 0.f;
        bf16x8 pb[2];
#pragma unroll
        for (int i = 0; i < 2; ++i) pb[i] = (bf16x8){0, 0, 0, 0, 0, 0, 0, 0};
        f32x16 p1k;
#pragma unroll
        for (int r = 0; r < 16; ++r) p1k[r] = 0.f;
        for (int h = 0; h < 2 * NT + 1; ++h) {
          if ((h & 3) == 0) { const int j2 = (h >> 1) + 2; if (j2 < NT) AT_DMA(j2); if (j2 + 1 < NT) AT_DMA(j2 + 1); }
          const int t2 = h - g;
          if (t2 >= 0 && t2 < 2 * NTw) {
            const int t = t2 >> 1;
            const LAS unsigned char* bb = lds + (t & 3) * 16384;
            const LAS unsigned char* bv = lds + 65536 + (t % 5) * 16384;
            if ((t2 & 1) == 0) {
            f32x16 p0, p1;
            bf16x8 kf[8];
#pragma unroll
            for (int d0 = 0; d0 < 4; ++d0) { kf[2 * d0] = *(const LAS bf16x8*)(bb + kro[d0]); kf[2 * d0 + 1] = *(const LAS bf16x8*)(bb + kro[d0] + 8192); }
            asm volatile("" : "+v"(kf[0]), "+v"(kf[1]), "+v"(kf[2]), "+v"(kf[3]), "+v"(kf[4]), "+v"(kf[5]), "+v"(kf[6]), "+v"(kf[7]));
            f32x16 negm; { float nm = -mref; asm volatile("" : "+v"(nm));
#pragma unroll
              for (int r = 0; r < 16; ++r) negm[r] = nm; }
            p0 = __builtin_amdgcn_mfma_f32_32x32x16_bf16(kf[0], qf[0], negm, 0, 0, 0); p1 = __builtin_amdgcn_mfma_f32_32x32x16_bf16(kf[1], qf[0], negm, 0, 0, 0);
#pragma unroll
            for (int d0 = 1; d0 < 4; ++d0) { p0 = __builtin_amdgcn_mfma_f32_32x32x16_bf16(kf[2 * d0], qf[d0], p0, 0, 0, 0); p1 = __builtin_amdgcn_mfma_f32_32x32x16_bf16(kf[2 * d0 + 1], qf[d0], p1, 0, 0, 0); }
            asm volatile("s_nop 15\n\ts_nop 7" : "+v"(p0), "+v"(p1));
            float mx;
            { float a = max3f(p0[0], p0[1], p1[0]), b2 = max3f(p0[2], p0[3], p1[1]); a = max3f(a, p1[2], p1[3]);
#pragma unroll
              for (int r = 4; r < 16; r += 4) { a = max3f(a, p0[r], p0[r + 1]); b2 = max3f(b2, p0[r + 2], p0[r + 3]); a = max3f(a, p1[r], p1[r + 1]); b2 = max3f(b2, p1[r + 2], p1[r + 3]); }
              mx = max3f(a, b2, b2);
              auto rr = __builtin_amdgcn_permlane32_swap(__float_as_uint(mx), __float_as_uint(mx), false, false); mx = max3f(__uint_as_float(rr[0]), __uint_as_float(rr[1]), __uint_as_float(rr[1])); }
            if (t == 0 || __builtin_amdgcn_ballot_w64(mx > 8.0f) != 0ull) {
                const float dl = (t == 0) ? mx : fmaxf(mx, 0.f);
                mref += dl;
#pragma unroll
                for (int r = 0; r < 16; ++r) { p0[r] -= dl; p1[r] -= dl; }
                if (t != 0) { const float f = __builtin_amdgcn_exp2f(-dl); lrun *= f;
#pragma unroll
                    for (int blk = 0; blk < 4; ++blk)
#pragma unroll
                        for (int r = 0; r < 16; ++r) o[blk][r] *= f; }
            }
            float ls0 = 0.f, ls2 = 0.f;
#pragma unroll
            for (int r = 0; r < 16; r += 2) { p0[r] = __builtin_amdgcn_exp2f(p0[r]); p0[r + 1] = __builtin_amdgcn_exp2f(p0[r + 1]); ls0 += p0[r]; ls2 += p0[r + 1]; }
            lrun += ls0 + ls2;
            { u32x4 w;
              w.x = cvtpk(p0[0], p0[1]); w.y = cvtpk(p0[2], p0[3]); w.z = cvtpk(p0[4], p0[5]); w.w = cvtpk(p0[6], p0[7]); pb[0] = __builtin_bit_cast(bf16x8, w);
              w.x = cvtpk(p0[8], p0[9]); w.y = cvtpk(p0[10], p0[11]); w.z = cvtpk(p0[12], p0[13]); w.w = cvtpk(p0[14], p0[15]); pb[1] = __builtin_bit_cast(bf16x8, w); }
            p1k = p1;
            } else {
            s16x4 fl[2][4], fh[2][4];
#define AT_LDV(bf, ss) do { _Pragma("unroll") for (int blk = 0; blk < 4; ++blk) { fl[bf][blk] = tr16(bv + vro[blk][0] + (ss) * 4096); fh[bf][blk] = tr16(bv + vro[blk][1] + (ss) * 4096); } } while (0)
#define AT_PINV(bf) asm volatile("" : "+v"(fl[bf][0]), "+v"(fl[bf][1]), "+v"(fl[bf][2]), "+v"(fl[bf][3]), "+v"(fh[bf][0]), "+v"(fh[bf][1]), "+v"(fh[bf][2]), "+v"(fh[bf][3]))
#define AT_MMV(bf, PB) do { _Pragma("unroll") for (int blk = 0; blk < 4; ++blk) { const bf16x8 va = (bf16x8){fl[bf][blk][0], fl[bf][blk][1], fl[bf][blk][2], fl[bf][blk][3], fh[bf][blk][0], fh[bf][blk][1], fh[bf][blk][2], fh[bf][blk][3]}; \
                o[blk] = __builtin_amdgcn_mfma_f32_32x32x16_bf16(va, PB, o[blk], 0, 0, 0); } } while (0)
            AT_LDV(0, 0); AT_LDV(1, 1);
            AT_PINV(0); AT_MMV(0, pb[0]);
            AT_LDV(0, 2);
            AT_PINV(1); AT_MMV(1, pb[1]);
            AT_LDV(1, 3);
            bf16x8 pc2, pc3;
            { float ls1 = 0.f, ls3 = 0.f;
#pragma unroll
              for (int r = 0; r < 16; r += 2) { p1k[r] = __builtin_amdgcn_exp2f(p1k[r]); p1k[r + 1] = __builtin_amdgcn_exp2f(p1k[r + 1]); ls1 += p1k[r]; ls3 += p1k[r + 1]; }
              lrun += ls1 + ls3;
              u32x4 w;
              w.x = cvtpk(p1k[0], p1k[1]); w.y = cvtpk(p1k[2], p1k[3]); w.z = cvtpk(p1k[4], p1k[5]); w.w = cvtpk(p1k[6], p1k[7]); pc2 = __builtin_bit_cast(bf16x8, w);
              w.x = cvtpk(p1k[8], p1k[9]); w.y = cvtpk(p1k[10], p1k[11]); w.z = cvtpk(p1k[12], p1k[13]); w.w = cvtpk(p1k[14], p1k[15]); pc3 = __builtin_bit_cast(bf16x8, w); }
            AT_PINV(0); AT_MMV(0, pc2);
            AT_PINV(1); AT_MMV(1, pc3);
#undef AT_LDV
#undef AT_PINV
#undef AT_MMV
            }
          }
          if ((h & 3) == 3) {
              asm volatile("s_waitcnt vmcnt(0) lgkmcnt(0)" ::: "memory"); __builtin_amdgcn_s_barrier(); asm volatile("" ::: "memory"); }
        }
        asm volatile("s_waitcnt lgkmcnt(0)" ::: "memory"); __builtin_amdgcn_s_barrier(); asm volatile("" ::: "memory");
#undef AT_DMA
        const float inv = 1.0f / (lrun + __shfl_xor(lrun, 32));
        LAS float* xch = (LAS float*)(lds + rg * 16384);
        if (g == 1 && NTw > 0) {
#pragma unroll
            for (int blk = 0; blk < 4; ++blk)
#pragma unroll
                for (int r = 0; r < 16; ++r) xch[(blk * 16 + r) * 64 + lane] = o[blk][r] * inv;
        }
        __syncthreads();
        if (g == 0 && NTw > 0) {
            float ss = 0.f;
#pragma unroll
            for (int blk = 0; blk < 4; ++blk)
#pragma unroll
                for (int r = 0; r < 16; ++r) { const float v = o[blk][r] * inv - lam * xch[(blk * 16 + r) * 64 + lane]; o[blk][r] = v; ss += v * v; }
            ss += __shfl_xor(ss, 32);
            const float rn = __builtin_amdgcn_rsqf(ss * (1.0f / 128.0f) + EPS) * (1.0f - LAMBDA_INIT);
            bf16_t* op = A2 + (size_t)(qrow0 + 32 * rg + l32) * 2048 + head * 128;
            const float* gn = P.in[15];
#pragma unroll
            for (int blk = 0; blk < 4; ++blk)
#pragma unroll
                for (int r4 = 0; r4 < 4; ++r4) { const int dv = 32 * blk + 8 * r4 + 4 * hi; const f32x4 gg = *(const f32x4*)(gn + dv);
                    u32x2 w; w.x = cvtpk(o[blk][4 * r4] * rn * gg[0], o[blk][4 * r4 + 1] * rn * gg[1]); w.y = cvtpk(o[blk][4 * r4 + 2] * rn * gg[2], o[blk][4 * r4 + 3] * rn * gg[3]);
                    *(u32x2*)(op + dv) = w; }
        }
    }
}

__device__ __forceinline__ void finalize_sample(const Params& P, const int wid_in, int S, const float* base, float scale, bf16_t* xb, float* ssq) {
    const int wave = wid_in, lane = pg8::opaque_lane();
    const int gw = blockIdx.x * NWAVES + wave, NGW = gridDim.x * NWAVES;
    const float* part = (const float*)(P.ws + WS_PART);
    for (int r = gw; r < MS; r += NGW) { const float* bp = base + (size_t)r * D_MODEL; float* op = P.out + (size_t)(MP + r) * D_MODEL; float q = 0.f;
#pragma unroll
        for (int j = 0; j < 8; ++j) { const int c = 256 * j + 4 * lane; f32x4 a = *(const f32x4*)(part + (size_t)r * D_MODEL + c);
            for (int s = 1; s < S; ++s) a += *(const f32x4*)(part + ((size_t)s * MS + r) * D_MODEL + c);
            const f32x4 o = *(const f32x4*)(bp + c) + a * scale; *(f32x4*)(op + c) = o; if (xb) *(u32x2*)(xb + (size_t)(MP + r) * D_MODEL + c) = pg8::pack4(o);
            q += (o[0] * o[0] + o[1] * o[1]) + (o[2] * o[2] + o[3] * o[3]); }
        q = wave_sum(q); if (lane == 0) ssq[MP + r] = q; }
}

constexpr int CW_PANEL = 65536;
__device__ __forceinline__ void norm_own_tiles(const Params& P, const int wid_in) {
    const int wave = wid_in, lane = pg8::opaque_lane();
    const int c = blockIdx.x, pm = 8 * (c & 7) + ((c >> 3) & 7), pn0 = c >> 6;
    unsigned* cnt = (unsigned*)(P.ws + WS_CTL) + CW_PANEL + 16 * pm;
    const float* ssq = (const float*)(P.ws + WS_CTL + 4096) + 2 * MROWS; const float* gn = P.in[22];
    asm volatile("s_waitcnt vmcnt(0)" ::: "memory"); __syncthreads();
    if (wave == 0 && lane == 0) { atomicAdd(cnt, 1u); unsigned sp = 0;
        while (__hip_atomic_load(cnt, __ATOMIC_RELAXED, __HIP_MEMORY_SCOPE_AGENT) < 4u && ++sp < (1u << 22)) __builtin_amdgcn_s_sleep(2); }
    __syncthreads();
    __builtin_amdgcn_fence(__ATOMIC_ACQUIRE, "agent");
    const f32x4 g0 = *(const f32x4*)(gn + 256 * pn0 + 4 * lane), g1 = *(const f32x4*)(gn + 256 * (pn0 + 4) + 4 * lane);
#pragma unroll 4
    for (int k = 0; k < 32; ++k) { const int row = 256 * pm + 32 * wave + k;
        const float rs = __builtin_amdgcn_rsqf(__hip_atomic_load(ssq + row, __ATOMIC_RELAXED, __HIP_MEMORY_SCOPE_AGENT) * (1.0f / D_MODEL) + EPS);
        float* xr = P.out + (size_t)row * D_MODEL + 4 * lane;
        const f32x4 v0 = *(const f32x4*)(xr + 256 * pn0), v1 = *(const f32x4*)(xr + 256 * (pn0 + 4));
        __builtin_nontemporal_store(v0 * rs * g0, (f32x4*)(xr + 256 * pn0)); __builtin_nontemporal_store(v1 * rs * g1, (f32x4*)(xr + 256 * (pn0 + 4))); }
}
__device__ __forceinline__ void final_norm_sample(const Params& P, const int wid_in) {
    const int wave = wid_in, lane = pg8::opaque_lane();
    const int gw = blockIdx.x * NWAVES + wave, NGW = gridDim.x * NWAVES;
    const float* gn = P.in[22]; const float* part = (const float*)(P.ws + WS_PART);
    for (int r = gw; r < MS; r += NGW) { float* xr = P.out + (size_t)(MP + r) * D_MODEL; f32x4 v[8]; float q = 0.f;
#pragma unroll
        for (int j = 0; j < 8; ++j) { const int cc = 256 * j + 4 * lane; f32x4 a = *(const f32x4*)(part + (size_t)r * D_MODEL + cc);
#pragma unroll
            for (int s = 1; s < 4; ++s) a += *(const f32x4*)(part + ((size_t)s * MS + r) * D_MODEL + cc);
            v[j] = *(const f32x4*)(xr + cc) + a * 0.5f; q += (v[j][0] * v[j][0] + v[j][1] * v[j][1]) + (v[j][2] * v[j][2] + v[j][3] * v[j][3]); }
        const float rs = __builtin_amdgcn_rsqf(wave_sum(q) * (1.0f / D_MODEL) + EPS);
#pragma unroll
        for (int j = 0; j < 8; ++j) { const int cc = 256 * j + 4 * lane; *(f32x4*)(xr + cc) = v[j] * rs * *(const f32x4*)(gn + cc); } }
}

#define XB_TMO      128
#define XB_XCNT(j)  (256  + 64 * (j))
#define XB_XSUB(j)  (1280 + 64 * (j))
#define XB_XGEN(j)  (2304 + 64 * (j))
#define XB_TOP      3328
#define XB_TOPGEN   3392
#define XCD_BAR_WORDS 3456
#define XB_SPIN_CAP (1u << 18)

__device__ __forceinline__ unsigned xb_ld(unsigned* p)              { return __hip_atomic_load(p, __ATOMIC_RELAXED, __HIP_MEMORY_SCOPE_AGENT); }
__device__ __forceinline__ unsigned xb_add(unsigned* p, unsigned v) { return __hip_atomic_fetch_add(p, v, __ATOMIC_RELAXED, __HIP_MEMORY_SCOPE_AGENT); }
__device__ __forceinline__ unsigned xb_xcc_id() { return (unsigned)__builtin_amdgcn_s_getreg((3 << 11) | 20) & 0xFu; }
#define XB_SPIN(cond, bar) do { unsigned _sp = 0; while (cond) { __builtin_amdgcn_s_sleep(1); \
    if ((++_sp & 255u) == 0u) { if (xb_ld(&(bar)[XB_TMO])) break; if (_sp > XB_SPIN_CAP) { atomicAdd(&(bar)[XB_TMO], 1u); break; } } } } while (0)

struct XcdBarrier {
    unsigned* bar; unsigned x;
    volatile LAS unsigned* st;
};

__device__ __forceinline__ XcdBarrier xcd_barrier_post(unsigned* bar, volatile LAS unsigned* st) {
    XcdBarrier b; b.bar = bar; b.x = xb_xcc_id(); b.st = st;
    if (threadIdx.x == 0) (void)xb_add(&bar[XB_XCNT(b.x)], 1u);
    return b;
}
__device__ __forceinline__ void xcd_barrier_complete(unsigned* bar, unsigned x, unsigned& nloc, unsigned& nx) {
    const unsigned G = gridDim.x * gridDim.y * gridDim.z;
    unsigned sum, cnt, mine, sp = 0u;
    for (;;) {
        sum = 0u; cnt = 0u; mine = 0u;
#pragma unroll
        for (unsigned j = 0; j < 16; ++j) { const unsigned c = xb_ld(&bar[XB_XCNT(j)]); sum += c; cnt += (c > 0u) ? 1u : 0u; mine = (j == x) ? c : mine; }
        if (sum == G) break;
        __builtin_amdgcn_s_sleep(1);
        if ((++sp & 255u) == 0u) { if (xb_ld(&bar[XB_TMO])) break; if (sp > XB_SPIN_CAP) { atomicAdd(&bar[XB_TMO], 1u); break; } }
    }
    nloc = mine > 0u ? mine : 1u; nx = cnt > 0u ? cnt : 1u;
}

__device__ __forceinline__ void xcd_barrier(const XcdBarrier& b) {
    asm volatile("s_waitcnt vmcnt(0)" ::: "memory");
    __syncthreads();
    if (threadIdx.x == 0) {
        unsigned* bar = b.bar;
        __builtin_amdgcn_s_waitcnt(0);
        unsigned nloc = b.st[0], nx = b.st[1];
        if (nloc == 0u) { xcd_barrier_complete(bar, b.x, nloc, nx); b.st[0] = nloc; b.st[1] = nx; }
        const unsigned old = xb_add(&bar[XB_XSUB(b.x)], 1u);
        const unsigned gen = old / nloc;
        if (old + 1u == (gen + 1u) * nloc) {
            __builtin_amdgcn_fence(__ATOMIC_RELEASE, "agent");
            asm volatile("s_waitcnt vmcnt(0)" ::: "memory");
            const unsigned og = xb_add(&bar[XB_TOP], 1u);
            const unsigned tg = og / nx;
            if (og + 1u == (tg + 1u) * nx) xb_add(&bar[XB_TOPGEN], 1u);
            else XB_SPIN(xb_ld(&bar[XB_TOPGEN]) == tg, bar);
            __builtin_amdgcn_fence(__ATOMIC_ACQUIRE, "agent");
            xb_add(&bar[XB_XGEN(b.x)], 1u);
            asm volatile("s_waitcnt vmcnt(0)" ::: "memory");
        } else {
            XB_SPIN(xb_ld(&bar[XB_XGEN(b.x)]) == gen, bar);
            __builtin_amdgcn_fence(__ATOMIC_ACQUIRE, "agent");
            asm volatile("s_waitcnt vmcnt(0)" ::: "memory");
        }
    }
    __syncthreads();
}

__global__ void __launch_bounds__(NTHREADS, 2) mega_fwd(Params P) {
    extern __shared__ __attribute__((aligned(16))) unsigned char lds_raw[];
    LAS unsigned char* lds = (LAS unsigned char*)lds_raw;
    cg::grid_group grid = cg::this_grid();
    unsigned char* ws = P.ws;
    const int G = gridDim.x, bx = blockIdx.x;
    const int wid_s = __builtin_amdgcn_readfirstlane(threadIdx.x >> 6);
    float* ssq = (float*)(ws + WS_CTL + 4096);
    bf16_t* XB = (bf16_t*)(ws + WS_XB); bf16_t* HB = (bf16_t*)(ws + WS_H);

    if (threadIdx.x < 8) ((LAS unsigned*)(lds + RING_BYTES))[threadIdx.x] = 0u;
    __syncthreads();
    prologue(P, lds, wid_s);
    grid.sync();
    const XcdBarrier bar = xcd_barrier_post((unsigned*)(ws + WS_CTL) + CW_BAR, (volatile LAS unsigned*)(lds + RING_BYTES + 16));
    { pg8::Gemm g{XB, (const bf16_t*)(ws + WS_W1GU), MROWS, 2 * FFN, D_MODEL, D_MODEL / 64}; pg8::StaticOrder S; S.init(MROWS, 2 * FFN, G, bx);
      pg8::EpiSwiGLU E{HB, FFN, nullptr};
      pg8::gemm_phase<pg8::EpiSwiGLU, pg8::StaticOrder, true, true>(lds, g, S, E, wid_s); }
    if (bx >= (68 * 44) % G) cache_convert_blocks(P, lds, wid_s, 6);
    xcd_barrier(bar);
    { pg8::Gemm g{HB, (const bf16_t*)(ws + WS_W1D), MP, D_MODEL, FFN, FFN / 64}; pg8::StaticOrder S; S.init(MP, D_MODEL, G, bx);
      pg8::EpiResid E{P.in[0], P.in[1], P.out, XB, ssq, 0.5f};
      pg8::gemm_phase<pg8::EpiResid, pg8::StaticOrder, true, true>(lds, g, S, E, wid_s); }
    { pg8::Gemm g{HB, (const bf16_t*)(ws + WS_W1D), MROWS, D_MODEL, FFN, FFN / 64 / 4}; pg8::SplitOrder S; S.init(4, FFN / 64 / 4, bx);
      pg8::EpiPartial E{(float*)(ws + WS_PART)};
      pg8::gemm_phase<pg8::EpiPartial, pg8::SplitOrder, false, true>(lds, g, S, E, wid_s);
      if ((bx >> 6) >= 2) cache_convert_blocks(P, lds, wid_s, 4); }
    xcd_barrier(bar);
    finalize_sample(P, wid_s, 4, P.in[1], 0.5f, XB, ssq);
    xcd_barrier(bar);
    { pg8::Gemm g{XB, (const bf16_t*)(ws + WS_WIN), MROWS, PROJ, D_MODEL, D_MODEL / 64}; pg8::StaticOrder S; S.init(MROWS, PROJ, G, bx);
      const float* cosT = (const float*)(ws + WS_ROPE);
      pg8::EpiProj E{ssq, cosT, cosT + 4096 * 32, (bf16_t*)(ws + WS_Q), (bf16_t*)(ws + WS_KP), (bf16_t*)(ws + WS_VP), (bf16_t*)(ws + WS_KS), (bf16_t*)(ws + WS_VS), (bf16_t*)(ws + WS_CB), (bf16_t*)(ws + WS_U),
                     P.out + O_KP, P.out + O_VP, P.out + O_KS, P.out + O_VS, P.out + O_CP, P.out + O_CS};
      pg8::gemm_phase<pg8::EpiProj, pg8::StaticOrder, true, true>(lds, g, S, E, wid_s); }
    if (bx >= (68 * 24) % G) cache_convert_blocks(P, lds, wid_s, 6);
    cache_convert_blocks(P, lds, wid_s, CV_BLOCKS);
    xcd_barrier(bar);
    conv_phase(P, wid_s);
    attn_phase(P, lds, wid_s);
    xcd_barrier(bar);
    { pg8::Gemm g{(const bf16_t*)(ws + WS_A2), (const bf16_t*)(ws + WS_WOUT), MP, D_MODEL, D_MODEL, D_MODEL / 64}; pg8::StaticOrder S; S.init(MP, D_MODEL, G, bx);
      pg8::EpiResid E{P.out, P.out + (size_t)MP * D_MODEL, P.out, XB, ssq + MROWS, 1.0f};
      pg8::gemm_phase<pg8::EpiResid, pg8::StaticOrder, true, true>(lds, g, S, E, wid_s); }
    { pg8::Gemm g{(const bf16_t*)(ws + WS_A2), (const bf16_t*)(ws + WS_WOUT), MROWS, D_MODEL, D_MODEL, D_MODEL / 64 / 8}; pg8::SplitOrder S; S.init(8, D_MODEL / 64 / 8, bx);
      pg8::EpiPartial E{(float*)(ws + WS_PART)};
      pg8::gemm_phase<pg8::EpiPartial, pg8::SplitOrder, false, true>(lds, g, S, E, wid_s); }
    xcd_barrier(bar);
    finalize_sample(P, wid_s, 8, P.out + (size_t)MP * D_MODEL, 1.0f, XB, ssq + MROWS);
    xcd_barrier(bar);
    { pg8::Gemm g{XB, (const bf16_t*)(ws + WS_W2GU), MROWS, 2 * FFN, D_MODEL, D_MODEL / 64}; pg8::StaticOrder S; S.init(MROWS, 2 * FFN, G, bx);
      pg8::EpiSwiGLU E{HB, FFN, ssq + MROWS};
      pg8::gemm_phase<pg8::EpiSwiGLU, pg8::StaticOrder, true, true>(lds, g, S, E, wid_s); }
    xcd_barrier(bar);
    { pg8::Gemm g{HB, (const bf16_t*)(ws + WS_W2D), MP, D_MODEL, FFN, FFN / 64}; pg8::StaticOrder S; S.init(MP, D_MODEL, G, bx);
      pg8::EpiResid E{P.out, P.out + (size_t)MP * D_MODEL, P.out, nullptr, ssq + 2 * MROWS, 0.5f};
      pg8::gemm_phase<pg8::EpiResid, pg8::StaticOrder, true, true>(lds, g, S, E, wid_s); }
    { pg8::Gemm g{HB, (const bf16_t*)(ws + WS_W2D), MROWS, D_MODEL, FFN, FFN / 64 / 4}; pg8::SplitOrder S; S.init(4, FFN / 64 / 4, bx);
      pg8::EpiPartial E{(float*)(ws + WS_PART)};
      pg8::gemm_phase<pg8::EpiPartial, pg8::SplitOrder, false, true>(lds, g, S, E, wid_s); }
    if (G == 256) norm_own_tiles(P, wid_s);
    xcd_barrier(bar);
    final_norm_sample(P, wid_s);
    if (G != 256) { const int lane = pg8::opaque_lane(); const float* ssqc = ssq + 2 * MROWS; const float* gn = P.in[22];
        for (int m = bx * NWAVES + wid_s; m < MP; m += G * NWAVES) { float* xr = P.out + (size_t)m * D_MODEL; const float rs = __builtin_amdgcn_rsqf(ssqc[m] * (1.0f / D_MODEL) + EPS);
            for (int j = 0; j < 8; ++j) { const f32x4 v = *(const f32x4*)(xr + 256 * j + 4 * lane), gg = *(const f32x4*)(gn + 256 * j + 4 * lane); *(f32x4*)(xr + 256 * j + 4 * lane) = v * rs * gg; } } }
}

extern "C" void kernel_launch(void* const* d_in, const int* in_sizes, int n_in, void* d_out, int out_size, void* d_ws, size_t ws_size, hipStream_t stream) {
    static int grid = 0;
    if (grid == 0) {
        if (n_in != 23 || (size_t)out_size != O_END || ws_size < WS_END) { fprintf(stderr, "kernel_launch: unexpected shapes (n_in %d out %d ws %zu)\n", n_in, out_size, ws_size); grid = -1; return; }
        int dev = 0, cus = 0, per_cu = 0;
        hipGetDevice(&dev); hipDeviceGetAttribute(&cus, hipDeviceAttributeMultiprocessorCount, dev);
        if (hipFuncSetAttribute((const void*)mega_fwd, hipFuncAttributeMaxDynamicSharedMemorySize, LDS_BYTES) != hipSuccess) { fprintf(stderr, "kernel_launch: hipFuncSetAttribute failed\n"); grid = -1; return; }
        if (hipOccupancyMaxActiveBlocksPerMultiprocessor(&per_cu, (const void*)mega_fwd, NTHREADS, LDS_BYTES) != hipSuccess || per_cu < 1) { fprintf(stderr, "kernel_launch: occupancy query says %d\n", per_cu); per_cu = 1; }
        (void)hipGetLastError();
        grid = cus;
        fprintf(stderr, "kernel_launch: grid %d (per_cu %d)\n", grid, per_cu);
    }
    if (grid < 0) return;
    Params p{};
    for (int i = 0; i < 23; ++i) p.in[i] = (const float*)d_in[i];
    p.out = (float*)d_out; p.ws = (unsigned char*)d_ws;
    void* args[] = {&p};
    hipError_t e = hipLaunchCooperativeKernel((const void*)mega_fwd, dim3(grid), dim3(NTHREADS), args, LDS_BYTES, stream);
    if (e != hipSuccess) fprintf(stderr, "cooperative launch failed: %s (grid %d)\n", hipGetErrorString(e), grid);
}
```

```cpp
#include <hip/hip_runtime.h>
#include <hip/hip_cooperative_groups.h>
#include <cstdio>
#include <cstdint>
#include <cmath>
namespace cg = cooperative_groups;
namespace pg8 {
#define PG8_LAS __attribute__((address_space(3)))
typedef unsigned short bf16_t;
typedef short bf16x8 __attribute__((ext_vector_type(8)));
typedef float f32x4 __attribute__((ext_vector_type(4)));
typedef unsigned u32x4 __attribute__((ext_vector_type(4)));
constexpr int BM = 256, BK = 64, HALF = 128, HTB = HALF * BK * 2  , STAGE_BYTES = 8 * HTB, NXCD = 8, WGM = 8;

__host__ __device__ __forceinline__ int lds_byte(int r, int c) { const int st = (r >> 4) * 2 + (c >> 5), rr = r & 15, cc = c & 31, ob = rr * 64 + cc * 2; return st * 1024 + (ob ^ (((ob >> 9) & 1) << 5)); }
__host__ __device__ __forceinline__ void stage_rc(int b, int& R, int& C) { const int st = b / 1024, sb = b % 1024, swz = sb ^ (((sb >> 9) & 1) << 5); R = (st >> 1) * 16 + swz / 64; C = (st & 1) * 32 + (swz % 64) / 2; }
__host__ __device__ __forceinline__ int perm32(int rho) { const int n = rho >> 4, i = rho & 15; return 8 * (i >> 2) + 4 * n + (i & 3); }

struct Unit { int pm, pn, kt0, ks; };
struct Gemm { const bf16_t* A; const bf16_t* Bt; int M, N, K, nt; };

struct StaticOrder {
    int nM, nN, nwg, G, c;
    __host__ __device__ void init(int M, int N, int G_, int c_) { nM = M / BM; nN = N / BM; nwg = nM * nN; G = G_; c = c_; }
    __host__ __device__ bool next(int i, Unit& u) const {
        const long L = (long)i * G + c; if (L >= nwg) return false;
        int wgid = (int)L; { const int q = nwg / NXCD, r = nwg % NXCD, xcd = wgid % NXCD, off = wgid / NXCD; wgid = (xcd < r ? xcd * (q + 1) : r * (q + 1) + (xcd - r) * q) + off; }
        const int nig = WGM * nN, gid = wgid / nig, fm = gid * WGM, gsz = (nM - fm) < WGM ? (nM - fm) : WGM;
        u.pm = fm + ((wgid % nig) % gsz); u.pn = (wgid % nig) / gsz; u.kt0 = 0; u.ks = 0; return true;
    }
    __device__ __forceinline__ void a_ready(const Unit&) const {}
    __device__ __forceinline__ void done(const Unit&) const {}
};

typedef unsigned u32x2 __attribute__((ext_vector_type(2)));
typedef float f32x2_t __attribute__((ext_vector_type(2)));
typedef __bf16 bf16x2_t __attribute__((ext_vector_type(2)));
__device__ __forceinline__ unsigned cvtpk(float lo, float hi) { f32x2_t v = {lo, hi}; bf16x2_t b = __builtin_convertvector(v, bf16x2_t); return __builtin_bit_cast(unsigned, b); }
__device__ __forceinline__ u32x2 pack4(f32x4 v) { u32x2 w; w.x = cvtpk(v[0], v[1]); w.y = cvtpk(v[2], v[3]); return w; }
__device__ __forceinline__ float silu1(float g) { return g * __builtin_amdgcn_rcpf(1.0f + __builtin_amdgcn_exp2f(-1.4426950408889634f * g)); }
__device__ __forceinline__ f32x4 silu_mul(f32x4 g, f32x4 u) { f32x4 o; o[0] = silu1(g[0]) * u[0]; o[1] = silu1(g[1]) * u[1]; o[2] = silu1(g[2]) * u[2]; o[3] = silu1(g[3]) * u[3]; return o; }

__device__ __forceinline__ int opaque_lane() { int l; asm volatile("v_mbcnt_lo_u32_b32 %0, -1, 0\n\tv_mbcnt_hi_u32_b32 %0, -1, %0" : "=v"(l)); return l; }
constexpr int E_MP = 16384;
constexpr int E_DM = 2048;
constexpr float E_EPS = 1e-6f;

struct EpiSwiGLU {
    static constexpr bool PERM = true, AFTER_DRAIN = false;
    bf16_t* H; int ldh; const float* ssq;
    __device__ __forceinline__ void operator()(const f32x4 (&acc)[2][2][4][2], const Unit& u, int wr, int wc, int fr, int fq) const {
        const int row0 = u.pm * BM + wr * 64 + fr; const int col0 = u.pn * HALF + wc * 32 + 8 * fq;
#pragma unroll
        for (int ai = 0; ai < 2; ++ai)
#pragma unroll
            for (int m = 0; m < 4; ++m) { const int row = row0 + ai * HALF + m * 16;
                float rs = 1.f; if (ssq) rs = __builtin_amdgcn_rsqf(ssq[row] * (1.0f / E_DM) + E_EPS);
                const f32x4 h0 = silu_mul(acc[ai][0][m][0] * rs, acc[ai][1][m][0] * rs), h1 = silu_mul(acc[ai][0][m][1] * rs, acc[ai][1][m][1] * rs);
                u32x4 w; w.x = cvtpk(h0[0], h0[1]); w.y = cvtpk(h0[2], h0[3]); w.z = cvtpk(h1[0], h1[1]); w.w = cvtpk(h1[2], h1[3]);
                *(u32x4*)(H + (size_t)row * ldh + col0) = w; }
    }
};

struct EpiResid {
    static constexpr bool PERM = false, AFTER_DRAIN = false;
    const float* base0; const float* base1; float* out; bf16_t* xb; float* ssq; float scale;
    __device__ __forceinline__ void operator()(const f32x4 (&acc)[2][2][4][2], const Unit& u, int wr, int wc, int fr, int fq) const {
        const int row0 = u.pm * BM + wr * 64 + fr; const int col0 = u.pn * BM + wc * 32 + 4 * fq;
#pragma unroll
        for (int ai = 0; ai < 2; ++ai)
#pragma unroll
            for (int m = 0; m < 4; ++m) { const int row = row0 + ai * HALF + m * 16;
                const float* bp = (row < E_MP) ? base0 + (size_t)row * E_DM : base1 + (size_t)(row - E_MP) * E_DM;
                float* op = out + (size_t)row * E_DM; float q = 0.f;
#pragma unroll
                for (int bj = 0; bj < 2; ++bj)
#pragma unroll
                    for (int n = 0; n < 2; ++n) { const int c = col0 + bj * HALF + n * 16; const f32x4 b = *(const f32x4*)(bp + c); const f32x4 o = b + acc[ai][bj][m][n] * scale;
                        *(f32x4*)(op + c) = o; if (xb) *(u32x2*)(xb + (size_t)row * E_DM + c) = pack4(o);
                        q += (o[0] * o[0] + o[1] * o[1]) + (o[2] * o[2] + o[3] * o[3]); }
                if (ssq) { q += __shfl_xor(q, 16); q += __shfl_xor(q, 32); if (fq == 0) atomicAdd(ssq + row, q); }
                asm volatile("" ::: "memory"); }
    }
};

struct EpiProj {
    static constexpr bool PERM = false, AFTER_DRAIN = false;
    const float* ssq; const float* cosT; const float* sinT;
    bf16_t* Q; bf16_t* Kp; bf16_t* Vp; bf16_t* Ks; bf16_t* Vs; bf16_t* CB; bf16_t* U;
    float* kout_p; float* vout_p; float* kout_s; float* vout_s; float* conv_p; float* conv_s;
    __device__ __forceinline__ void operator()(const f32x4 (&acc)[2][2][4][2], const Unit& u, int wr, int wc, int fr, int fq) const {
        const int row0 = u.pm * BM + wr * 64 + fr; const int pn = u.pn;
        constexpr float C2 = 0.125f * 1.4426950408889634f;
#pragma unroll
        for (int ai = 0; ai < 2; ++ai)
#pragma unroll
            for (int m = 0; m < 4; ++m) { const int row = row0 + ai * HALF + m * 16;
                const float rs = __builtin_amdgcn_rsqf(ssq[row] * (1.0f / E_DM) + E_EPS);
                const bool samp = row >= E_MP; const int rsx = row - E_MP;
                const int pos = samp ? 2048 + (rsx & 63) : (row & 4095);
                const size_t kvrow = samp ? (size_t)((rsx >> 6) * 2112 + 2048 + (rsx & 63)) : (size_t)row;
                if (pn < 8) {
                    const int i0 = 16 * (wc & 1) + 4 * fq; const int mp = wc >> 1;
                    const f32x4 c4 = *(const f32x4*)(cosT + pos * 32 + i0), s4 = *(const f32x4*)(sinT + pos * 32 + i0);
#pragma unroll
                    for (int bj = 0; bj < 2; ++bj) { const int head = 2 * (pn & 3) + bj; const int col = head * 128 + mp * 64 + i0;
                        const f32x4 x1 = acc[ai][bj][m][0] * rs, x2 = acc[ai][bj][m][1] * rs;
                        f32x4 y1 = x1 * c4 - x2 * s4, y2 = x2 * c4 + x1 * s4;
                        if (pn < 4) { y1 = y1 * C2; y2 = y2 * C2; bf16_t* qp = Q + (size_t)row * 1024 + col; *(u32x2*)qp = pack4(y1); *(u32x2*)(qp + 32) = pack4(y2); }
                        else { float* ko = (samp ? kout_s + (size_t)rsx * 1024 : kout_p + (size_t)row * 1024) + col; __builtin_nontemporal_store(y1, (f32x4*)ko); __builtin_nontemporal_store(y2, (f32x4*)(ko + 32));
                               bf16_t* kb = (samp ? Ks : Kp) + kvrow * 1024 + col; *(u32x2*)kb = pack4(y1); *(u32x2*)(kb + 32) = pack4(y2); } }
                } else if (pn < 12) {
#pragma unroll
                    for (int bj = 0; bj < 2; ++bj)
#pragma unroll
                        for (int n = 0; n < 2; ++n) { const int col = (pn - 8) * BM + bj * HALF + wc * 32 + n * 16 + 4 * fq; const f32x4 v = acc[ai][bj][m][n] * rs;
                            float* vo = (samp ? vout_s + (size_t)rsx * 1024 : vout_p + (size_t)row * 1024) + col; __builtin_nontemporal_store(v, (f32x4*)vo);
                            *(u32x2*)((samp ? Vs : Vp) + kvrow * 1024 + col) = pack4(v); }
                } else if (pn < 16) {
#pragma unroll
                    for (int bj = 0; bj < 2; ++bj)
#pragma unroll
                        for (int n = 0; n < 2; ++n) { const int col = (pn - 12) * BM + bj * HALF + wc * 32 + n * 16 + 4 * fq; *(u32x2*)(CB + (size_t)row * 1024 + col) = pack4(acc[ai][bj][m][n] * rs); }
                } else {
                    const int t = samp ? (rsx & 63) : (row & 4095); const int tl = samp ? 62 : 4094;
#pragma unroll
                    for (int n = 0; n < 2; ++n) { const int col = (pn - 16) * HALF + wc * 32 + n * 16 + 4 * fq; const f32x4 uu = (acc[ai][0][m][n] * rs) * (acc[ai][1][m][n] * rs);
                        *(u32x2*)(U + (size_t)row * 1024 + col) = pack4(uu);
                        if (t >= tl) { float* cp = samp ? conv_s + (size_t)((rsx >> 6) * 2 + (t - tl)) * 1024 : conv_p + (size_t)((row >> 12) * 2 + (t - tl)) * 1024; *(f32x4*)(cp + col) = uu; } }
                }
                asm volatile("" ::: "memory"); }
    }
};


struct SplitOrder {
    int S, nt, c;
    __host__ __device__ void init(int S_, int nt_, int c_) { S = S_; nt = nt_; c = c_; }
    __host__ __device__ bool next(int i, Unit& u) const {
        if (i != 0) return false;
        const int xcd = c & 7, slot = c >> 3, per = (4 * S) >> 3, cl = slot >> 3;
        if (cl >= per) return false;
        const int combo = xcd * per + cl; u.pm = 64 + combo / S; u.ks = combo % S; u.kt0 = u.ks * nt; u.pn = slot & 7; return true;
    }
    __device__ __forceinline__ void a_ready(const Unit&) const {}
    __device__ __forceinline__ void done(const Unit&) const {}
};
struct EpiPartial {
    static constexpr bool PERM = false, AFTER_DRAIN = false;
    float* part;
    __device__ __forceinline__ void operator()(const f32x4 (&acc)[2][2][4][2], const Unit& u, int wr, int wc, int fr, int fq) const {
        const int row0 = (u.pm - 64) * BM + wr * 64 + fr; const int col0 = u.pn * BM + wc * 32 + 4 * fq;
        float* pb = part + (size_t)u.ks * 1024 * E_DM;
#pragma unroll
        for (int ai = 0; ai < 2; ++ai)
#pragma unroll
            for (int m = 0; m < 4; ++m) { float* op = pb + (size_t)(row0 + ai * HALF + m * 16) * E_DM + col0;
#pragma unroll
                for (int bj = 0; bj < 2; ++bj)
#pragma unroll
                    for (int n = 0; n < 2; ++n) *(f32x4*)(op + bj * HALF + n * 16) = acc[ai][bj][m][n]; }
    }
};
template <class Epi, class Sched, bool ALIGN_EPI = false, bool SP2 = false>
__device__ __forceinline__ void gemm_phase(PG8_LAS unsigned char* lds, const Gemm g, const Sched& S, const Epi& E, const int wid_in) {
    const int wid = wid_in, lane = opaque_lane(), tid = wid * 64 + lane, wr = wid >> 2, wc = wid & 3, fr = lane & 15, fq = lane >> 4;
    const int K = g.K, nt = g.nt;
    unsigned voffA[2], voffB[2];
#pragma unroll
    for (int i = 0; i < 2; ++i) { int R, C; stage_rc(tid * 16 + i * 8192, R, C); const int Rb = Epi::PERM ? ((R & ~31) + perm32(R & 31)) : R;
        voffA[i] = (unsigned)(R * K + C) * 2u; voffB[i] = (unsigned)(Rb * K + C) * 2u; }
    const size_t kstep = (size_t)(BK * 2);
    const size_t hstep = (size_t)HALF * K * 2;
    const size_t tstep = 2 * hstep;
    const unsigned ldsw = (unsigned)wid * 1024u;
    const int aoff = lds_byte(wr * 64 + fr, fq * 8), boff = lds_byte(wc * 32 + fr, fq * 8);
#define PG8_SA(b, h) (((b) * 2 + (h)) * HTB)
#define PG8_SB(b, h) ((4 + (b) * 2 + (h)) * HTB)
#define PG8_STAGE(bufoff, gbase, voff) do { _Pragma("unroll") for (int _i = 0; _i < 2; ++_i) \
        __builtin_amdgcn_global_load_lds((const unsigned*)((const char*)(gbase) + (voff)[_i]), (PG8_LAS unsigned*)(lds + (bufoff) + ldsw + _i * 8192), 16, 0, 0); } while (0)
#define PG8_LDA(dst, b, h) do { _Pragma("unroll") for (int m = 0; m < 4; ++m) _Pragma("unroll") for (int k = 0; k < 2; ++k) dst[m][k] = *(const PG8_LAS bf16x8*)(lds + PG8_SA(b, h) + aoff + m * 2048 + k * 1024); } while (0)
#define PG8_LDB(dst, b, h) do { _Pragma("unroll") for (int n = 0; n < 2; ++n) _Pragma("unroll") for (int k = 0; k < 2; ++k) dst[n][k] = *(const PG8_LAS bf16x8*)(lds + PG8_SB(b, h) + boff + n * 2048 + k * 1024); } while (0)
#define PG8_MMA(ai, bj, At, Bt) do { __builtin_amdgcn_s_setprio(1); _Pragma("unroll") for (int m = 0; m < 4; ++m) _Pragma("unroll") for (int n = 0; n < 2; ++n) _Pragma("unroll") for (int k = 0; k < 2; ++k) \
        acc[ai][bj][m][n] = __builtin_amdgcn_mfma_f32_16x16x32_bf16(Bt[n][k], At[m][k], acc[ai][bj][m][n], 0, 0, 0); __builtin_amdgcn_s_setprio(0); } while (0)
#define PG8_WAIT_V(n) asm volatile("s_waitcnt vmcnt(" #n ")" ::: "memory")
#define PG8_WAIT_L(n) asm volatile("s_waitcnt lgkmcnt(" #n ")" ::: "memory")
#define PG8_BAR __builtin_amdgcn_s_barrier()
#define PG8_SCHED __builtin_amdgcn_sched_barrier(0)
    Unit cur, nxt; int ui = 0;
    if (!S.next(0, cur)) return;
    f32x4 acc[2][2][4][2];
#pragma unroll
    for (int a = 0; a < 2; ++a)
#pragma unroll
        for (int b = 0; b < 2; ++b)
#pragma unroll
            for (int m = 0; m < 4; ++m)
#pragma unroll
                for (int n = 0; n < 2; ++n) acc[a][b][m][n] = (f32x4){0.f, 0.f, 0.f, 0.f};
    bf16x8 At[4][2], B0[2][2], B1[2][2];
    const char* cA = (const char*)g.A + (size_t)cur.pm * tstep + (size_t)cur.kt0 * kstep; const char* cB = (const char*)g.Bt + (size_t)cur.pn * tstep + (size_t)cur.kt0 * kstep;
    S.a_ready(cur);
    if constexpr (SP2) {
        PG8_STAGE(PG8_SB(0, 0), cB, voffB); PG8_STAGE(PG8_SB(0, 1), cB + hstep, voffB); PG8_STAGE(PG8_SA(0, 0), cA, voffA); PG8_STAGE(PG8_SA(0, 1), cA + hstep, voffA);
        if (wr == 1) PG8_BAR;
        PG8_WAIT_V(2); PG8_BAR;
        PG8_STAGE(PG8_SB(1, 0), cB + kstep, voffB); PG8_STAGE(PG8_SA(1, 0), cA + kstep, voffA); PG8_STAGE(PG8_SB(1, 1), cB + hstep + kstep, voffB);
        PG8_WAIT_V(6); PG8_BAR;
    } else {
        PG8_STAGE(PG8_SB(0, 0), cB, voffB); PG8_STAGE(PG8_SA(0, 0), cA, voffA); PG8_STAGE(PG8_SB(0, 1), cB + hstep, voffB); PG8_STAGE(PG8_SA(0, 1), cA + hstep, voffA);
        if (wr == 1) PG8_BAR;
        PG8_WAIT_V(4); PG8_BAR;
        PG8_STAGE(PG8_SB(1, 0), cB + kstep, voffB); PG8_STAGE(PG8_SA(1, 0), cA + kstep, voffA); PG8_STAGE(PG8_SB(1, 1), cB + hstep + kstep, voffB);
        PG8_WAIT_V(6); PG8_BAR;
    }
    for (;;) {
        const bool has_next = S.next(ui + 1, nxt);
        const char* nA = has_next ? (const char*)g.A + (size_t)nxt.pm * tstep + (size_t)nxt.kt0 * kstep : cA; const char* nB = has_next ? (const char*)g.Bt + (size_t)nxt.pn * tstep + (size_t)nxt.kt0 * kstep : cB;
        for (int t = 0; t < nt; t += 2) {
            const bool last = (t == nt - 2);
            const char* a1 = cA + (size_t)(t + 1) * kstep;
            const char* a2 = last ? nA : cA + (size_t)(t + 2) * kstep; const char* b2 = last ? nB : cB + (size_t)(t + 2) * kstep;
            const char* a3 = a2 + kstep; const char* b3 = b2 + kstep;
            if (last && has_next) S.a_ready(nxt);
            if constexpr (SP2) {
            PG8_LDB(B0, 0, 0); PG8_LDB(B1, 0, 1); PG8_SCHED; PG8_LDA(At, 0, 0); PG8_STAGE(PG8_SA(1, 1), a1 + hstep, voffA);
            PG8_WAIT_V(8); PG8_WAIT_L(0); PG8_BAR; PG8_MMA(0, 0, At, B0); PG8_MMA(0, 1, At, B1); PG8_BAR; PG8_SCHED;
            PG8_LDA(At, 0, 1); PG8_STAGE(PG8_SB(0, 0), b2, voffB); PG8_STAGE(PG8_SB(0, 1), b2 + hstep, voffB); PG8_STAGE(PG8_SA(0, 0), a2, voffA);
            PG8_WAIT_V(8); PG8_WAIT_L(0); PG8_BAR; PG8_MMA(1, 0, At, B0); PG8_MMA(1, 1, At, B1); PG8_BAR; PG8_SCHED;
            PG8_LDB(B0, 1, 0); PG8_LDB(B1, 1, 1); PG8_SCHED; PG8_LDA(At, 1, 0); PG8_STAGE(PG8_SA(0, 1), a2 + hstep, voffA);
            PG8_WAIT_V(8); PG8_WAIT_L(0); PG8_BAR; PG8_MMA(0, 0, At, B0); PG8_MMA(0, 1, At, B1); PG8_BAR; PG8_SCHED;
            PG8_LDA(At, 1, 1); PG8_STAGE(PG8_SB(1, 0), b3, voffB); PG8_STAGE(PG8_SB(1, 1), b3 + hstep, voffB); PG8_STAGE(PG8_SA(1, 0), a3, voffA);
            PG8_WAIT_V(8); PG8_WAIT_L(0); PG8_BAR; PG8_MMA(1, 0, At, B0); PG8_MMA(1, 1, At, B1); PG8_BAR; PG8_SCHED;
            } else {
            PG8_LDB(B0, 0, 0); PG8_SCHED; PG8_LDA(At, 0, 0); PG8_STAGE(PG8_SA(1, 1), a1 + hstep, voffA);
            PG8_WAIT_L(8); PG8_BAR; PG8_WAIT_L(0); PG8_MMA(0, 0, At, B0); PG8_BAR; PG8_SCHED;
            PG8_LDB(B1, 0, 1); PG8_STAGE(PG8_SB(0, 0), b2, voffB);
            PG8_BAR; PG8_WAIT_L(0); PG8_MMA(0, 1, At, B1); PG8_BAR;
            PG8_LDA(At, 0, 1); PG8_STAGE(PG8_SA(0, 0), a2, voffA);
            PG8_BAR; PG8_WAIT_L(0); PG8_MMA(1, 0, At, B0); PG8_BAR; PG8_SCHED;
            PG8_STAGE(PG8_SB(0, 1), b2 + hstep, voffB);
            PG8_WAIT_V(6); PG8_BAR; PG8_MMA(1, 1, At, B1); PG8_BAR;
            PG8_LDB(B0, 1, 0); PG8_SCHED; PG8_LDA(At, 1, 0); PG8_STAGE(PG8_SA(0, 1), a2 + hstep, voffA);
            PG8_WAIT_L(8); PG8_BAR; PG8_WAIT_L(0); PG8_MMA(0, 0, At, B0); PG8_BAR; PG8_SCHED;
            PG8_LDB(B1, 1, 1); PG8_STAGE(PG8_SB(1, 0), b3, voffB);
            PG8_BAR; PG8_WAIT_L(0); PG8_MMA(0, 1, At, B1); PG8_BAR;
            PG8_LDA(At, 1, 1); PG8_STAGE(PG8_SA(1, 0), a3, voffA);
            PG8_BAR; PG8_WAIT_L(0); PG8_MMA(1, 0, At, B0); PG8_BAR; PG8_SCHED;
            PG8_STAGE(PG8_SB(1, 1), b3 + hstep, voffB);
            PG8_WAIT_V(6); PG8_BAR; PG8_MMA(1, 1, At, B1); PG8_BAR;
            }
        }
        if constexpr (ALIGN_EPI) { if (wr == 0) PG8_BAR; }
        if constexpr (!Epi::AFTER_DRAIN) { E(acc, cur, wr, wc, fr, fq); S.done(cur); }
        if (!has_next) break;
#pragma unroll
        for (int a = 0; a < 2; ++a)
#pragma unroll
            for (int b = 0; b < 2; ++b)
#pragma unroll
                for (int m = 0; m < 4; ++m)
#pragma unroll
                    for (int n = 0; n < 2; ++n) acc[a][b][m][n] = (f32x4){0.f, 0.f, 0.f, 0.f};
        cur = nxt; cA = nA; cB = nB; ++ui;
        if constexpr (ALIGN_EPI) { if (wr == 1) PG8_BAR; }
    }
    PG8_WAIT_V(0);
    if constexpr (!ALIGN_EPI) { if (wr == 0) PG8_BAR; }
    PG8_BAR;
    if constexpr (Epi::AFTER_DRAIN) { E.fused(acc, cur, wr, wc, fr, fq, lds, wid, lane); S.done(cur); }
#undef PG8_SA
#undef PG8_SB
#undef PG8_STAGE
#undef PG8_LDA
#undef PG8_LDB
#undef PG8_MMA
#undef PG8_WAIT_V
#undef PG8_WAIT_L
#undef PG8_BAR
#undef PG8_SCHED
}
}

#define LAS __attribute__((address_space(3)))
typedef unsigned short bf16_t;
typedef short bf16x8 __attribute__((ext_vector_type(8)));
typedef short s16x4 __attribute__((ext_vector_type(4)));
typedef float f32x4 __attribute__((ext_vector_type(4)));
typedef float f32x16 __attribute__((ext_vector_type(16)));
typedef unsigned u32x4 __attribute__((ext_vector_type(4)));
typedef unsigned u32x2 __attribute__((ext_vector_type(2)));
using pg8::cvtpk;

constexpr int NWAVES = 8, NTHREADS = 512;
constexpr int D_MODEL = 2048, FFN = 5632, PROJ = 6144;
constexpr int MP = 16384, MS = 1024, MROWS = MP + MS;
constexpr int SEQ = 4096, DSEQ = 64, PAST = 2048, SKV = PAST + DSEQ;
constexpr float EPS = 1e-6f;
constexpr float LAMBDA_INIT = 0.2f;

constexpr size_t MiB = 1u << 20;
constexpr size_t WS_CTL = 0;
constexpr size_t WS_ROPE = 1 * MiB;
constexpr size_t WS_W1GU = 2 * MiB, WS_W1D = 46 * MiB, WS_WIN = 68 * MiB, WS_WOUT = 92 * MiB, WS_W2GU = 100 * MiB, WS_W2D = 144 * MiB;
constexpr size_t WS_XB = 166 * MiB;
constexpr size_t WS_H = 234 * MiB;
constexpr size_t WS_Q = 234 * MiB, WS_U = 268 * MiB, WS_CB = 302 * MiB, WS_A2 = 336 * MiB;
constexpr size_t WS_KP = 421 * MiB, WS_VP = 453 * MiB, WS_KS = 485 * MiB, WS_VS = 551 * MiB, WS_PART = 617 * MiB, WS_END = 681 * MiB;
static_assert(WS_A2 + (size_t)MROWS * 2048 * 2 <= WS_KP && WS_H + (size_t)MROWS * FFN * 2 <= WS_KP, "ws map");

constexpr size_t O_Y = 0, O_KP = 35651584, O_VP = 52428800, O_CP = 69206016, O_KS = 69214208, O_VS = 70262784, O_CS = 71311360, O_END = 71344128;

constexpr int RING_BYTES = 147456, LDS_BYTES = RING_BYTES + 1024;
constexpr int CW_BAR = 131072;
constexpr int XCD_BAR_WORDS_C = 3456;

struct Params { const float* in[23]; float* out; unsigned char* ws; };

__device__ __forceinline__ float wave_sum(float v) {
#pragma unroll
    for (int o = 1; o < 64; o <<= 1) v += __shfl_xor(v, o);
    return v;
}

__device__ __forceinline__ void transpose_item(const float* W, int ldw, int coff, int K, const float* gain, bf16_t* WT, int dbase, int hstride, int dadd, bool swp,
                                               LAS float* scr, int kb, int nb, int lane) {
    const int k0 = 64 * kb, n0 = 32 * nb;
    { f32x4 w[8]; const int c4 = 4 * (lane & 7);
#pragma unroll
      for (int i = 0; i < 8; ++i) w[i] = __builtin_nontemporal_load((const f32x4*)(W + (size_t)(k0 + 8 * i + (lane >> 3)) * ldw + coff + n0 + c4));
#pragma unroll
      for (int i = 0; i < 8; ++i) { const int kk = 8 * i + (lane >> 3); const float gg = gain ? gain[k0 + kk] : 1.0f; LAS float* d = scr + kk * 33 + c4;
          d[0] = w[i][0] * gg; d[1] = w[i][1] * gg; d[2] = w[i][2] * gg; d[3] = w[i][3] * gg; } }
    asm volatile("s_waitcnt lgkmcnt(0)" ::: "memory");
    const int c = lane & 7;
#pragma unroll
    for (int j = 0; j < 4; ++j) { const int n = (lane >> 3) + 8 * j; const LAS float* s = scr + (8 * c) * 33 + n;
        u32x4 o; o.x = cvtpk(s[0 * 33], s[1 * 33]); o.y = cvtpk(s[2 * 33], s[3 * 33]); o.z = cvtpk(s[4 * 33], s[5 * 33]); o.w = cvtpk(s[6 * 33], s[7 * 33]);
        const int col = n0 + n; int low = col & 127; if (swp) low = (low & ~48) | ((low & 16) << 1) | ((low & 32) >> 1);
        const int drow = dbase + (col >> 7) * hstride + dadd + low;
        *(u32x4*)(WT + (size_t)drow * K + k0 + 8 * c) = o; }
    asm volatile("s_waitcnt lgkmcnt(0)" ::: "memory");
}

__device__ __forceinline__ void prologue(const Params& P, LAS unsigned char* lds, const int wid_in) {
    const int wave = wid_in, lane = pg8::opaque_lane(), tid = wave * 64 + lane;
    const int gw = blockIdx.x * NWAVES + wave, NGW = gridDim.x * NWAVES;
    const int gt = blockIdx.x * NTHREADS + tid, NGT = gridDim.x * NTHREADS;
    unsigned char* ws = P.ws;
    { unsigned* ctl = (unsigned*)(ws + WS_CTL); if (gt < 9) ctl[64 * gt] = 0u; if (gt < 64) ctl[65536 + 16 * gt] = 0u; for (int i = gt; i < XCD_BAR_WORDS_C; i += NGT) ctl[CW_BAR + i] = 0u; float* ssq = (float*)(ws + WS_CTL + 4096); for (int i = gt; i < 3 * MROWS; i += NGT) ssq[i] = 0.f; }
    { float* cosT = (float*)(ws + WS_ROPE); float* sinT = cosT + 4096 * 32;
      for (int e = gt; e < 4096 * 32; e += NGT) { const int pos = e >> 5, i = e & 31;
          const float inv = exp2f(-(float)i * 0.41524101186092029f);
          const float ang = (float)pos * inv;
          double r = (double)ang; r -= 6.283185307179586477 * rint(r * 0.15915494309189533577);
          const double r2 = r * r;
          double s = -1.0 / 25852016738884976640000.0;
          s = s * r2 + 1.0 / 51090942171709440000.0;
          s = s * r2 - 1.0 / 121645100408832000.0;
          s = s * r2 + 1.0 / 355687428096000.0;
          s = s * r2 - 1.0 / 1307674368000.0;
          s = s * r2 + 1.0 / 6227020800.0;
          s = s * r2 - 1.0 / 39916800.0;
          s = s * r2 + 1.0 / 362880.0;
          s = s * r2 - 1.0 / 5040.0;
          s = s * r2 + 1.0 / 120.0;
          s = s * r2 - 1.0 / 6.0;
          s = s * r2 + 1.0; s *= r;
          double c = 1.0 / 1124000727777607680000.0;
          c = c * r2 - 1.0 / 2432902008176640000.0;
          c = c * r2 + 1.0 / 6402373705728000.0;
          c = c * r2 - 1.0 / 20922789888000.0;
          c = c * r2 + 1.0 / 87178291200.0;
          c = c * r2 - 1.0 / 479001600.0;
          c = c * r2 + 1.0 / 3628800.0;
          c = c * r2 - 1.0 / 40320.0;
          c = c * r2 + 1.0 / 720.0;
          c = c * r2 - 1.0 / 24.0;
          c = c * r2 + 0.5; c = 1.0 - c * r2;
          cosT[e] = (float)c; sinT[e] = (float)s; } }
    { LAS float* scr = (LAS float*)(lds + wave * 16384);
      constexpr int I_GU = (D_MODEL / 64) * (FFN / 32), I_D = (FFN / 64) * (D_MODEL / 32), I_S = (D_MODEL / 64) * (1024 / 32), I_O = (D_MODEL / 64) * (D_MODEL / 32);
      constexpr int NITEMS = 4 * I_GU + 2 * I_D + 6 * I_S + I_O;
      bf16_t* W1GU = (bf16_t*)(ws + WS_W1GU); bf16_t* W1D = (bf16_t*)(ws + WS_W1D); bf16_t* WIN = (bf16_t*)(ws + WS_WIN); bf16_t* WOUT = (bf16_t*)(ws + WS_WOUT);
      bf16_t* W2GU = (bf16_t*)(ws + WS_W2GU); bf16_t* W2D = (bf16_t*)(ws + WS_W2D);
      for (int it = gw; it < NITEMS; it += NGW) { int r = it;
          if (r < I_GU) { transpose_item(P.in[6], FFN, 0, D_MODEL, P.in[5], W1GU, 0, 256, 0, false, scr, r / (FFN / 32), r % (FFN / 32), lane); continue; } r -= I_GU;
          if (r < I_GU) { transpose_item(P.in[7], FFN, 0, D_MODEL, P.in[5], W1GU, 0, 256, 128, false, scr, r / (FFN / 32), r % (FFN / 32), lane); continue; } r -= I_GU;
          if (r < I_GU) { transpose_item(P.in[19], FFN, 0, D_MODEL, P.in[18], W2GU, 0, 256, 0, false, scr, r / (FFN / 32), r % (FFN / 32), lane); continue; } r -= I_GU;
          if (r < I_GU) { transpose_item(P.in[20], FFN, 0, D_MODEL, P.in[18], W2GU, 0, 256, 128, false, scr, r / (FFN / 32), r % (FFN / 32), lane); continue; } r -= I_GU;
          if (r < I_D) { transpose_item(P.in[8], D_MODEL, 0, FFN, nullptr, W1D, 0, 128, 0, false, scr, r / (D_MODEL / 32), r % (D_MODEL / 32), lane); continue; } r -= I_D;
          if (r < I_D) { transpose_item(P.in[21], D_MODEL, 0, FFN, nullptr, W2D, 0, 128, 0, false, scr, r / (D_MODEL / 32), r % (D_MODEL / 32), lane); continue; } r -= I_D;
          if (r < I_S) { transpose_item(P.in[10], PROJ, 0, D_MODEL, P.in[9], WIN, 0, 128, 0, true, scr, r / 32, r % 32, lane); continue; } r -= I_S;
          if (r < I_S) { transpose_item(P.in[10], PROJ, 1024, D_MODEL, P.in[9], WIN, 1024, 128, 0, true, scr, r / 32, r % 32, lane); continue; } r -= I_S;
          if (r < I_S) { transpose_item(P.in[10], PROJ, 2048, D_MODEL, P.in[9], WIN, 2048, 128, 0, false, scr, r / 32, r % 32, lane); continue; } r -= I_S;
          if (r < I_S) { transpose_item(P.in[10], PROJ, 3072, D_MODEL, P.in[9], WIN, 3072, 128, 0, false, scr, r / 32, r % 32, lane); continue; } r -= I_S;
          if (r < I_S) { transpose_item(P.in[10], PROJ, 4096, D_MODEL, P.in[9], WIN, 4096, 256, 0, false, scr, r / 32, r % 32, lane); continue; } r -= I_S;
          if (r < I_S) { transpose_item(P.in[10], PROJ, 5120, D_MODEL, P.in[9], WIN, 4096, 256, 128, false, scr, r / 32, r % 32, lane); continue; } r -= I_S;
          transpose_item(P.in[17], D_MODEL, 0, D_MODEL, nullptr, WOUT, 0, 128, 0, false, scr, r / (D_MODEL / 32), r % (D_MODEL / 32), lane);
      } }
    { bf16_t* XB = (bf16_t*)(ws + WS_XB);
      for (int m = gw; m < MROWS; m += NGW) { const float* xr = (m < MP) ? P.in[0] + (size_t)m * D_MODEL : P.in[1] + (size_t)(m - MP) * D_MODEL;
          f32x4 v[8]; float s = 0.f;
#pragma unroll
          for (int j = 0; j < 8; ++j) { v[j] = __builtin_nontemporal_load((const f32x4*)(xr + 256 * j + 4 * lane)); s += (v[j][0] * v[j][0] + v[j][1] * v[j][1]) + (v[j][2] * v[j][2] + v[j][3] * v[j][3]); }
          const float rs = __builtin_amdgcn_rsqf(wave_sum(s) * (1.0f / D_MODEL) + EPS);
#pragma unroll
          for (int j = 0; j < 8; ++j) *(u32x2*)(XB + (size_t)m * D_MODEL + 256 * j + 4 * lane) = pg8::pack4(v[j] * rs); } }
}

constexpr int CV_BLOCKS = 2 * 16 * PAST * 1024 / 32768;
__device__ __forceinline__ void cache_convert_blocks(const Params& P, LAS unsigned char* lds, const int wid_in, int max_blocks) {
    const int lane = pg8::opaque_lane(), tid = wid_in * 64 + lane;
    unsigned* counter = (unsigned*)(P.ws + WS_CTL) + 64 * 8;
    LAS unsigned* slot = (LAS unsigned*)(lds + RING_BYTES + 8);
    bf16_t* KS = (bf16_t*)(P.ws + WS_KS); bf16_t* VS = (bf16_t*)(P.ws + WS_VS);
    for (int n = 0; n < max_blocks; ++n) {
        __syncthreads();
        if (tid == 0) *slot = atomicAdd(counter, 1u);
        __syncthreads();
        const int blk = (int)*slot;
        if (blk >= CV_BLOCKS) break;
        const int which = blk >= CV_BLOCKS / 2; const size_t el0 = (size_t)(which ? blk - CV_BLOCKS / 2 : blk) * 32768;
        const float* src = (which ? P.in[3] : P.in[2]) + el0; bf16_t* dst = which ? VS : KS;
#pragma unroll
        for (int half = 0; half < 2; ++half) { f32x4 a[4], c[4];
#pragma unroll
            for (int k = 0; k < 4; ++k) { const float* sp = src + (size_t)((half * 4 + k) * NTHREADS + tid) * 8; a[k] = __builtin_nontemporal_load((const f32x4*)sp); c[k] = __builtin_nontemporal_load((const f32x4*)(sp + 4)); }
#pragma unroll
            for (int k = 0; k < 4; ++k) { const size_t el = el0 + (size_t)((half * 4 + k) * NTHREADS + tid) * 8; const int b = (int)(el >> 21); const size_t rem = el & ((1u << 21) - 1);
                u32x4 w; w.x = cvtpk(a[k][0], a[k][1]); w.y = cvtpk(a[k][2], a[k][3]); w.z = cvtpk(c[k][0], c[k][1]); w.w = cvtpk(c[k][2], c[k][3]);
                *(u32x4*)(dst + (size_t)b * SKV * 1024 + rem) = w; } }
    }
}

__device__ __forceinline__ void bf8_to_f32(u32x4 w, float (&f)[8]) {
#pragma unroll
    for (int i = 0; i < 4; ++i) { f[2 * i] = __uint_as_float(w[i] << 16); f[2 * i + 1] = __uint_as_float(w[i] & 0xffff0000u); }
}
__device__ __forceinline__ void conv_phase(const Params& P, const int wid_in) {
    const int wave = wid_in, lane = pg8::opaque_lane();
    const int gw = blockIdx.x * NWAVES + wave, NGW = gridDim.x * NWAVES;
    const bf16_t* U = (const bf16_t*)(P.ws + WS_U); const bf16_t* CB = (const bf16_t*)(P.ws + WS_CB); bf16_t* A2 = (bf16_t*)(P.ws + WS_A2);
    const float* cw = P.in[16]; const float* st = P.in[4];
    for (int it = gw; it < (MROWS / 8) * 2; it += NGW) { const int row0 = (it >> 1) * 8, c0 = (it & 1) * 512 + lane * 8;
        const bool samp = row0 >= MP; const int rsx0 = row0 - MP; const int t0 = samp ? (rsx0 & 63) : (row0 & 4095); const int b = rsx0 >> 6;
        u32x4 ur[8], cr[8], hr0, hr1; f32x4 sa0, sc0, sa1, sc1;
#pragma unroll
        for (int i = 0; i < 8; ++i) { ur[i] = *(const u32x4*)(U + (size_t)(row0 + i) * 1024 + c0); cr[i] = *(const u32x4*)(CB + (size_t)(row0 + i) * 1024 + c0); }
        float p2[8], p1[8], w0[8], w1[8], w2[8];
        if (t0 > 0) { hr0 = *(const u32x4*)(U + (size_t)(row0 - 2) * 1024 + c0); hr1 = *(const u32x4*)(U + (size_t)(row0 - 1) * 1024 + c0); bf8_to_f32(hr0, p2); bf8_to_f32(hr1, p1); }
        else if (samp) { const float* sp = st + (size_t)(b * 2) * 1024 + c0; sa0 = *(const f32x4*)sp; sc0 = *(const f32x4*)(sp + 4); sa1 = *(const f32x4*)(sp + 1024); sc1 = *(const f32x4*)(sp + 1028);
#pragma unroll
            for (int i = 0; i < 4; ++i) { p2[i] = sa0[i]; p2[4 + i] = sc0[i]; p1[i] = sa1[i]; p1[4 + i] = sc1[i]; } }
        else {
#pragma unroll
            for (int i = 0; i < 8; ++i) { p2[i] = 0.f; p1[i] = 0.f; } }
        { const f32x4 a = *(const f32x4*)(cw + c0), c = *(const f32x4*)(cw + c0 + 4); for (int i = 0; i < 4; ++i) { w0[i] = a[i]; w0[4 + i] = c[i]; } }
        { const f32x4 a = *(const f32x4*)(cw + 1024 + c0), c = *(const f32x4*)(cw + 1024 + c0 + 4); for (int i = 0; i < 4; ++i) { w1[i] = a[i]; w1[4 + i] = c[i]; } }
        { const f32x4 a = *(const f32x4*)(cw + 2048 + c0), c = *(const f32x4*)(cw + 2048 + c0 + 4); for (int i = 0; i < 4; ++i) { w2[i] = a[i]; w2[4 + i] = c[i]; } }
#pragma unroll
        for (int r = 0; r < 8; ++r) { float cur[8], cb[8], o[8]; bf8_to_f32(ur[r], cur); bf8_to_f32(cr[r], cb);
#pragma unroll
            for (int i = 0; i < 8; ++i) { o[i] = cb[i] * (w0[i] * p2[i] + w1[i] * p1[i] + w2[i] * cur[i]); p2[i] = p1[i]; p1[i] = cur[i]; }
            u32x4 w; w.x = cvtpk(o[0], o[1]); w.y = cvtpk(o[2], o[3]); w.z = cvtpk(o[4], o[5]); w.w = cvtpk(o[6], o[7]);
            *(u32x4*)(A2 + (size_t)(row0 + r) * 2048 + 1024 + c0) = w; } }
}

constexpr int NUNITS = 1024 + 64;
__device__ __forceinline__ s16x4 tr16(const LAS unsigned char* p) {
    typedef short v4i16_t __attribute__((ext_vector_type(4)));
    return __builtin_bit_cast(s16x4, __builtin_amdgcn_ds_read_tr16_b64_v4i16((LAS v4i16_t*)p));
}
__device__ __forceinline__ void glds16(const void* gsrc, unsigned lds_dst) { unsigned keep;
    asm volatile("s_mov_b32 %0, m0\n\ts_mov_b32 m0, %2\n\ts_nop 0\n\tglobal_load_lds_dwordx4 %1, off\n\ts_mov_b32 m0, %0" : "=&s"(keep) : "v"(gsrc), "s"(lds_dst) : "memory"); }
__device__ __forceinline__ float max3f(float a, float b, float c) { float r; asm("v_max3_f32 %0, %1, %2, %3" : "=v"(r) : "v"(a), "v"(b), "v"(c)); return r; }
__device__ __forceinline__ void attn_phase(const Params& P, LAS unsigned char* lds, const int wid_in) {
    const int wid = wid_in, lane = pg8::opaque_lane(), tid = wid * 64 + lane;
    const int g = wid >> 2, rg = wid & 3;
    const int l32 = lane & 31, hi = lane >> 5;
    const bf16_t* Q = (const bf16_t*)(P.ws + WS_Q); bf16_t* A2 = (bf16_t*)(P.ws + WS_A2);
    unsigned* counter = (unsigned*)(P.ws + WS_CTL);
    LAS unsigned* qslot = (LAS unsigned*)(lds + RING_BYTES);
    float lam;
    { const float a = P.in[11][lane] * P.in[12][lane], b = P.in[13][lane] * P.in[14][lane]; lam = __expf(wave_sum(a)) - __expf(wave_sum(b)) + LAMBDA_INIT; }
    const int r2 = lane >> 4, pc = lane & 15;
    const unsigned lds0 = (unsigned)(uintptr_t)lds;
    unsigned koffv[2], voffv[2];
#pragma unroll
    for (int i = 0; i < 2; ++i) { const int row = 8 * wid + 4 * i + r2; koffv[i] = (unsigned)(row * 2048 + 16 * (pc ^ (row & 15))); voffv[i] = (unsigned)(row * 2048 + 16 * (pc ^ (((row & 3) << 2) | ((row >> 2) & 3)))); }
    unsigned kro[4];
#pragma unroll
    for (int d0 = 0; d0 < 4; ++d0) { const int ch = 8 * g + 2 * d0 + hi; kro[d0] = (unsigned)(l32 * 256 + 16 * (ch ^ (l32 & 15))); }
    const int i16 = lane & 15, q_ = i16 >> 2, p_ = i16 & 3, gcol = (lane >> 4) & 1;
    unsigned vro[4][2];
#pragma unroll
    for (int blk = 0; blk < 4; ++blk)
#pragma unroll
        for (int sec = 0; sec < 2; ++sec) { const int row = 4 * hi + 8 * sec + q_; const int c = 4 * blk + 2 * gcol + (p_ >> 1); const int swz = ((row & 3) << 2) | ((row >> 2) & 3);
            vro[blk][sec] = (unsigned)(256 * row + 16 * (c ^ swz) + 8 * (p_ & 1)); }
    int myq = (int)(__builtin_amdgcn_s_getreg((3 << 11) | 20) & 7u), tries = 0;
    for (;;) {
        __syncthreads();
        if (tid == 0) *qslot = atomicAdd(counter + 64 * myq, 1u);
        __syncthreads();
        const int ui = (int)*qslot;
        if (ui >= 144) { if (++tries == 8) break; myq = (myq + 1) & 7; continue; }
        int b, head, NT, NTw, qrow0; const bf16_t* Kb; const bf16_t* Vb;
        if (ui >= 60 && ui < 76) { const int s = 16 * myq + (ui - 60); b = s >> 3; head = s & 7; NT = 33; NTw = (rg < 2) ? 33 : 0; qrow0 = MP + 64 * b;
            Kb = (const bf16_t*)(P.ws + WS_KS) + (size_t)b * SKV * 1024; Vb = (const bf16_t*)(P.ws + WS_VS) + (size_t)b * SKV * 1024; }
        else { int cp, pr; if (ui < 60) { cp = 31 - (ui >> 2); pr = 4 * myq + (ui & 3); } else { const int v = ui - 76; cp = 16 - (v >> 2); pr = 4 * myq + (v & 3); }
            b = pr >> 3; head = pr & 7; NT = 2 * cp + 2; NTw = NT - ((rg < 2) ? 1 : 0); qrow0 = b * SEQ + 128 * cp;
            Kb = (const bf16_t*)(P.ws + WS_KP) + (size_t)b * SEQ * 1024; Vb = (const bf16_t*)(P.ws + WS_VP) + (size_t)b * SEQ * 1024; }
        const char* kgb = (const char*)Kb + head * 256; const char* vgb = (const char*)Vb + head * 256;
#define AT_DMA(k) do { const int k_ = (k); const unsigned lk_ = lds0 + (unsigned)((k_ & 3) * 16384 + wid * 2048), lv_ = lds0 + 65536u + (unsigned)((k_ % 5) * 16384 + wid * 2048); const size_t to_ = (size_t)k_ * 131072; _Pragma("unroll") for (int i = 0; i < 2; ++i) { \
            glds16(kgb + to_ + koffv[i], (unsigned)__builtin_amdgcn_readfirstlane(lk_ + i * 1024)); glds16(vgb + to_ + voffv[i], (unsigned)__builtin_amdgcn_readfirstlane(lv_ + i * 1024)); } } while (0)
        AT_DMA(0); AT_DMA(1);
        bf16x8 qf[4];
        { int qrow = qrow0 + 32 * rg + l32; qrow = qrow < MROWS ? qrow : MROWS - 1;
          const bf16_t* qp = Q + (size_t)qrow * 1024 + head * 128 + g * 64 + hi * 8;
#pragma unroll
          for (int d0 = 0; d0 < 4; ++d0) qf[d0] = *(const bf16x8*)(qp + 16 * d0); }
        asm volatile("" : "+v"(qf[0]), "+v"(qf[1]), "+v"(qf[2]), "+v"(qf[3]));
        asm volatile("s_waitcnt vmcnt(0) lgkmcnt(0)" ::: "memory"); __builtin_amdgcn_s_barrier(); asm volatile("" ::: "memory");
        f32x16 o[4];
#pragma unroll
        for (int blk = 0; blk < 4; ++blk)
#pragma unroll
            for (int r = 0; r < 16; ++r) o[blk][r] = 0.f;
        f32x16 negm;
#pragma unroll
        for (int r = 0; r < 16; ++r) negm[r] = 0.f;
        asm volatile("" : "+v"(negm));
        float mref = 0.f, lrun = 0.f;
        bf16x8 pb[2];
#pragma unroll
        for (int i = 0; i < 2; ++i) pb[i] = (bf16x8){0, 0, 0, 0, 0, 0, 0, 0};
        f32x16 p1k;
#pragma unroll
        for (int r = 0; r < 16; ++r) p1k[r] = 0.f;
        for (int h = 0; h < 2 * NT + 1; ++h) {
          if ((h & 3) == 0) { const int j2 = (h >> 1) + 2; if (j2 < NT) AT_DMA(j2); if (j2 + 1 < NT) AT_DMA(j2 + 1); }
          const int t2 = h - g;
          if (t2 >= 0 && t2 < 2 * NTw) {
            const int t = t2 >> 1;
            const LAS unsigned char* bb = lds + (t & 3) * 16384;
            const LAS unsigned char* bv = lds + 65536 + (t % 5) * 16384;
            if ((t2 & 1) == 0) {
            f32x16 p0, p1;
            bf16x8 kf[8];
#pragma unroll
            for (int d0 = 0; d0 < 4; ++d0) { kf[2 * d0] = *(const LAS bf16x8*)(bb + kro[d0]); kf[2 * d0 + 1] = *(const LAS bf16x8*)(bb + kro[d0] + 8192); }
            asm volatile("" : "+v"(kf[0]), "+v"(kf[1]), "+v"(kf[2]), "+v"(kf[3]), "+v"(kf[4]), "+v"(kf[5]), "+v"(kf[6]), "+v"(kf[7]));
            p0 = __builtin_amdgcn_mfma_f32_32x32x16_bf16(kf[0], qf[0], negm, 0, 0, 0); p1 = __builtin_amdgcn_mfma_f32_32x32x16_bf16(kf[1], qf[0], negm, 0, 0, 0);
#pragma unroll
            for (int d0 = 1; d0 < 4; ++d0) { p0 = __builtin_amdgcn_mfma_f32_32x32x16_bf16(kf[2 * d0], qf[d0], p0, 0, 0, 0); p1 = __builtin_amdgcn_mfma_f32_32x32x16_bf16(kf[2 * d0 + 1], qf[d0], p1, 0, 0, 0); }
            asm volatile("s_nop 15\n\ts_nop 7" : "+v"(p0), "+v"(p1));
            float mx;
            { float a = max3f(p0[0], p0[1], p1[0]), b2 = max3f(p0[2], p0[3], p1[1]); a = max3f(a, p1[2], p1[3]);
#pragma unroll
              for (int r = 4; r < 16; r += 4) { a = max3f(a, p0[r], p0[r + 1]); b2 = max3f(b2, p0[r + 2], p0[r + 3]); a = max3f(a, p1[r], p1[r + 1]); b2 = max3f(b2, p1[r + 2], p1[r + 3]); }
              mx = max3f(a, b2, b2);
              auto rr = __builtin_amdgcn_permlane32_swap(__float_as_uint(mx), __float_as_uint(mx), false, false); mx = max3f(__uint_as_float(rr[0]), __uint_as_float(rr[1]), __uint_as_float(rr[1])); }
            if (t == 0 || __builtin_amdgcn_ballot_w64(mx > 8.0f) != 0ull) {
                const float dl = (t == 0) ? mx : fmaxf(mx, 0.f);
                mref += dl;
#pragma unroll
                for (int r = 0; r < 16; ++r) { p0[r] -= dl; p1[r] -= dl; }
#pragma unroll
                for (int r = 0; r < 16; ++r) negm[r] = -mref;
                asm volatile("" : "+v"(negm));
                if (t != 0) { const float f = __builtin_amdgcn_exp2f(-dl); lrun *= f;
#pragma unroll
                    for (int blk = 0; blk < 4; ++blk)
#pragma unroll
                        for (int r = 0; r < 16; ++r) o[blk][r] *= f; }
            }
            float ls0 = 0.f, ls2 = 0.f;
#pragma unroll
            for (int r = 0; r < 16; r += 2) { p0[r] = __builtin_amdgcn_exp2f(p0[r]); p0[r + 1] = __builtin_amdgcn_exp2f(p0[r + 1]); ls0 += p0[r]; ls2 += p0[r + 1]; }
            lrun += ls0 + ls2;
            { u32x4 w;
              w.x = cvtpk(p0[0], p0[1]); w.y = cvtpk(p0[2], p0[3]); w.z = cvtpk(p0[4], p0[5]); w.w = cvtpk(p0[6], p0[7]); pb[0] = __builtin_bit_cast(bf16x8, w);
              w.x = cvtpk(p0[8], p0[9]); w.y = cvtpk(p0[10], p0[11]); w.z = cvtpk(p0[12], p0[13]); w.w = cvtpk(p0[14], p0[15]); pb[1] = __builtin_bit_cast(bf16x8, w); }
            p1k = p1;
            } else {
#pragma unroll
            for (int s = 0; s < 2; ++s) { s16x4 vl[4], vh[4];
#pragma unroll
                for (int blk = 0; blk < 4; ++blk) { vl[blk] = tr16(bv + vro[blk][0] + s * 4096); vh[blk] = tr16(bv + vro[blk][1] + s * 4096); }
#pragma unroll
                for (int blk = 0; blk < 4; ++blk) { const bf16x8 va = (bf16x8){vl[blk][0], vl[blk][1], vl[blk][2], vl[blk][3], vh[blk][0], vh[blk][1], vh[blk][2], vh[blk][3]};
                    o[blk] = __builtin_amdgcn_mfma_f32_32x32x16_bf16(va, pb[s], o[blk], 0, 0, 0); } }
            bf16x8 pc2, pc3;
            { float ls1 = 0.f, ls3 = 0.f;
#pragma unroll
              for (int r = 0; r < 16; r += 2) { p1k[r] = __builtin_amdgcn_exp2f(p1k[r]); p1k[r + 1] = __builtin_amdgcn_exp2f(p1k[r + 1]); ls1 += p1k[r]; ls3 += p1k[r + 1]; }
              lrun += ls1 + ls3;
              u32x4 w;
              w.x = cvtpk(p1k[0], p1k[1]); w.y = cvtpk(p1k[2], p1k[3]); w.z = cvtpk(p1k[4], p1k[5]); w.w = cvtpk(p1k[6], p1k[7]); pc2 = __builtin_bit_cast(bf16x8, w);
              w.x = cvtpk(p1k[8], p1k[9]); w.y = cvtpk(p1k[10], p1k[11]); w.z = cvtpk(p1k[12], p1k[13]); w.w = cvtpk(p1k[14], p1k[15]); pc3 = __builtin_bit_cast(bf16x8, w); }
#pragma unroll
            for (int s = 2; s < 4; ++s) { s16x4 vl[4], vh[4];
#pragma unroll
                for (int blk = 0; blk < 4; ++blk) { vl[blk] = tr16(bv + vro[blk][0] + s * 4096); vh[blk] = tr16(bv + vro[blk][1] + s * 4096); }
#pragma unroll
                for (int blk = 0; blk < 4; ++blk) { const bf16x8 va = (bf16x8){vl[blk][0], vl[blk][1], vl[blk][2], vl[blk][3], vh[blk][0], vh[blk][1], vh[blk][2], vh[blk][3]};
                    o[blk] = __builtin_amdgcn_mfma_f32_32x32x16_bf16(va, s == 2 ? pc2 : pc3, o[blk], 0, 0, 0); } }
            }
          }
          if ((h & 3) == 3) {
              asm volatile("s_waitcnt vmcnt(0) lgkmcnt(0)" ::: "memory"); __builtin_amdgcn_s_barrier(); asm volatile("" ::: "memory"); }
        }
        asm volatile("s_waitcnt lgkmcnt(0)" ::: "memory"); __builtin_amdgcn_s_barrier(); asm volatile("" ::: "memory");
#undef AT_DMA
        const float inv = 1.0f / (lrun + __shfl_xor(lrun, 32));
        LAS float* xch = (LAS float*)(lds + rg * 16384);
        if (g == 1 && NTw > 0) {
#pragma unroll
            for (int blk = 0; blk < 4; ++blk)
#pragma unroll
                for (int r = 0; r < 16; ++r) xch[(blk * 16 + r) * 64 + lane] = o[blk][r] * inv;
        }
        __syncthreads();
        if (g == 0 && NTw > 0) {
            float ss = 0.f;
#pragma unroll
            for (int blk = 0; blk < 4; ++blk)
#pragma unroll
                for (int r = 0; r < 16; ++r) { const float v = o[blk][r] * inv - lam * xch[(blk * 16 + r) * 64 + lane]; o[blk][r] = v; ss += v * v; }
            ss += __shfl_xor(ss, 32);
            const float rn = __builtin_amdgcn_rsqf(ss * (1.0f / 128.0f) + EPS) * (1.0f - LAMBDA_INIT);
            bf16_t* op = A2 + (size_t)(qrow0 + 32 * rg + l32) * 2048 + head * 128;
            const float* gn = P.in[15];
#pragma unroll
            for (int blk = 0; blk < 4; ++blk)
#pragma unroll
                for (int rp = 0; rp < 2; ++rp) { u32x2 we, wo;
                    { const int dv = 32 * blk + 16 * rp + 4 * hi; const f32x4 gg = *(const f32x4*)(gn + dv); const int r = 8 * rp;
                      we.x = cvtpk(o[blk][r] * rn * gg[0], o[blk][r + 1] * rn * gg[1]); we.y = cvtpk(o[blk][r + 2] * rn * gg[2], o[blk][r + 3] * rn * gg[3]); }
                    { const int dv = 32 * blk + 16 * rp + 8 + 4 * hi; const f32x4 gg = *(const f32x4*)(gn + dv); const int r = 8 * rp + 4;
                      wo.x = cvtpk(o[blk][r] * rn * gg[0], o[blk][r + 1] * rn * gg[1]); wo.y = cvtpk(o[blk][r + 2] * rn * gg[2], o[blk][r + 3] * rn * gg[3]); }
                    const auto s0 = __builtin_amdgcn_permlane32_swap(we.x, wo.x, false, false), s1 = __builtin_amdgcn_permlane32_swap(we.y, wo.y, false, false);
                    u32x4 w; w.x = s0[0]; w.y = s1[0]; w.z = s0[1]; w.w = s1[1];
                    *(u32x4*)(op + 32 * blk + 16 * rp + 8 * hi) = w; }
        }
    }
}

__device__ __forceinline__ void finalize_sample(const Params& P, const int wid_in, int S, const float* base, float scale, bf16_t* xb, float* ssq) {
    const int wave = wid_in, lane = pg8::opaque_lane();
    const int gw = blockIdx.x * NWAVES + wave, NGW = gridDim.x * NWAVES;
    const float* part = (const float*)(P.ws + WS_PART);
    for (int r = gw; r < MS; r += NGW) { const float* bp = base + (size_t)r * D_MODEL; float* op = P.out + (size_t)(MP + r) * D_MODEL; float q = 0.f;
#pragma unroll
        for (int j = 0; j < 8; ++j) { const int c = 256 * j + 4 * lane; f32x4 a = *(const f32x4*)(part + (size_t)r * D_MODEL + c);
            for (int s = 1; s < S; ++s) a += *(const f32x4*)(part + ((size_t)s * MS + r) * D_MODEL + c);
            const f32x4 o = *(const f32x4*)(bp + c) + a * scale; *(f32x4*)(op + c) = o; if (xb) *(u32x2*)(xb + (size_t)(MP + r) * D_MODEL + c) = pg8::pack4(o);
            q += (o[0] * o[0] + o[1] * o[1]) + (o[2] * o[2] + o[3] * o[3]); }
        q = wave_sum(q); if (lane == 0) ssq[MP + r] = q; }
}

constexpr int CW_PANEL = 65536;
__device__ __forceinline__ void norm_own_tiles(const Params& P, const int wid_in) {
    const int wave = wid_in, lane = pg8::opaque_lane();
    const int c = blockIdx.x, pm = 8 * (c & 7) + ((c >> 3) & 7), pn0 = c >> 6;
    unsigned* cnt = (unsigned*)(P.ws + WS_CTL) + CW_PANEL + 16 * pm;
    const float* ssq = (const float*)(P.ws + WS_CTL + 4096) + 2 * MROWS; const float* gn = P.in[22];
    asm volatile("s_waitcnt vmcnt(0)" ::: "memory"); __syncthreads();
    if (wave == 0 && lane == 0) { atomicAdd(cnt, 1u); unsigned sp = 0;
        while (__hip_atomic_load(cnt, __ATOMIC_RELAXED, __HIP_MEMORY_SCOPE_AGENT) < 4u && ++sp < (1u << 22)) __builtin_amdgcn_s_sleep(2); }
    __syncthreads();
    __builtin_amdgcn_fence(__ATOMIC_ACQUIRE, "agent");
    const f32x4 g0 = *(const f32x4*)(gn + 256 * pn0 + 4 * lane), g1 = *(const f32x4*)(gn + 256 * (pn0 + 4) + 4 * lane);
#pragma unroll 4
    for (int k = 0; k < 32; ++k) { const int row = 256 * pm + 32 * wave + k;
        const float rs = __builtin_amdgcn_rsqf(__hip_atomic_load(ssq + row, __ATOMIC_RELAXED, __HIP_MEMORY_SCOPE_AGENT) * (1.0f / D_MODEL) + EPS);
        float* xr = P.out + (size_t)row * D_MODEL + 4 * lane;
        const f32x4 v0 = *(const f32x4*)(xr + 256 * pn0), v1 = *(const f32x4*)(xr + 256 * (pn0 + 4));
        __builtin_nontemporal_store(v0 * rs * g0, (f32x4*)(xr + 256 * pn0)); __builtin_nontemporal_store(v1 * rs * g1, (f32x4*)(xr + 256 * (pn0 + 4))); }
}
__device__ __forceinline__ void final_norm_sample(const Params& P, const int wid_in) {
    const int wave = wid_in, lane = pg8::opaque_lane();
    const int gw = blockIdx.x * NWAVES + wave, NGW = gridDim.x * NWAVES;
    const float* gn = P.in[22]; const float* part = (const float*)(P.ws + WS_PART);
    for (int r = gw; r < MS; r += NGW) { float* xr = P.out + (size_t)(MP + r) * D_MODEL; f32x4 v[8]; float q = 0.f;
#pragma unroll
        for (int j = 0; j < 8; ++j) { const int cc = 256 * j + 4 * lane; f32x4 a = *(const f32x4*)(part + (size_t)r * D_MODEL + cc);
#pragma unroll
            for (int s = 1; s < 4; ++s) a += *(const f32x4*)(part + ((size_t)s * MS + r) * D_MODEL + cc);
            v[j] = *(const f32x4*)(xr + cc) + a * 0.5f; q += (v[j][0] * v[j][0] + v[j][1] * v[j][1]) + (v[j][2] * v[j][2] + v[j][3] * v[j][3]); }
        const float rs = __builtin_amdgcn_rsqf(wave_sum(q) * (1.0f / D_MODEL) + EPS);
#pragma unroll
        for (int j = 0; j < 8; ++j) { const int cc = 256 * j + 4 * lane; *(f32x4*)(xr + cc) = v[j] * rs * *(const f32x4*)(gn + cc); } }
}

#define XB_TMO      128
#define XB_XCNT(j)  (256  + 64 * (j))
#define XB_XSUB(j)  (1280 + 64 * (j))
#define XB_XGEN(j)  (2304 + 64 * (j))
#define XB_TOP      3328
#define XB_TOPGEN   3392
#define XCD_BAR_WORDS 3456
#define XB_SPIN_CAP (1u << 18)

__device__ __forceinline__ unsigned xb_ld(unsigned* p)              { return __hip_atomic_load(p, __ATOMIC_RELAXED, __HIP_MEMORY_SCOPE_AGENT); }
__device__ __forceinline__ unsigned xb_add(unsigned* p, unsigned v) { return __hip_atomic_fetch_add(p, v, __ATOMIC_RELAXED, __HIP_MEMORY_SCOPE_AGENT); }
__device__ __forceinline__ unsigned xb_xcc_id() { return (unsigned)__builtin_amdgcn_s_getreg((3 << 11) | 20) & 0xFu; }
#define XB_SPIN(cond, bar) do { unsigned _sp = 0; while (cond) { __builtin_amdgcn_s_sleep(1); \
    if ((++_sp & 255u) == 0u) { if (xb_ld(&(bar)[XB_TMO])) break; if (_sp > XB_SPIN_CAP) { atomicAdd(&(bar)[XB_TMO], 1u); break; } } } } while (0)

struct XcdBarrier {
    unsigned* bar; unsigned x;
    volatile LAS unsigned* st;
};

__device__ __forceinline__ XcdBarrier xcd_barrier_post(unsigned* bar, volatile LAS unsigned* st) {
    XcdBarrier b; b.bar = bar; b.x = xb_xcc_id(); b.st = st;
    if (threadIdx.x == 0) (void)xb_add(&bar[XB_XCNT(b.x)], 1u);
    return b;
}
__device__ __forceinline__ void xcd_barrier_complete(unsigned* bar, unsigned x, unsigned& nloc, unsigned& nx) {
    const unsigned G = gridDim.x * gridDim.y * gridDim.z;
    unsigned sum, cnt, mine, sp = 0u;
    for (;;) {
        sum = 0u; cnt = 0u; mine = 0u;
#pragma unroll
        for (unsigned j = 0; j < 16; ++j) { const unsigned c = xb_ld(&bar[XB_XCNT(j)]); sum += c; cnt += (c > 0u) ? 1u : 0u; mine = (j == x) ? c : mine; }
        if (sum == G) break;
        __builtin_amdgcn_s_sleep(1);
        if ((++sp & 255u) == 0u) { if (xb_ld(&bar[XB_TMO])) break; if (sp > XB_SPIN_CAP) { atomicAdd(&bar[XB_TMO], 1u); break; } }
    }
    nloc = mine > 0u ? mine : 1u; nx = cnt > 0u ? cnt : 1u;
}

__device__ __forceinline__ void xcd_barrier(const XcdBarrier& b) {
    asm volatile("s_waitcnt vmcnt(0)" ::: "memory");
    __syncthreads();
    if (threadIdx.x == 0) {
        unsigned* bar = b.bar;
        __builtin_amdgcn_s_waitcnt(0);
        unsigned nloc = b.st[0], nx = b.st[1];
        if (nloc == 0u) { xcd_barrier_complete(bar, b.x, nloc, nx); b.st[0] = nloc; b.st[1] = nx; }
        const unsigned old = xb_add(&bar[XB_XSUB(b.x)], 1u);
        const unsigned gen = old / nloc;
        if (old + 1u == (gen + 1u) * nloc) {
            __builtin_amdgcn_fence(__ATOMIC_RELEASE, "agent");
            asm volatile("s_waitcnt vmcnt(0)" ::: "memory");
            const unsigned og = xb_add(&bar[XB_TOP], 1u);
            const unsigned tg = og / nx;
            if (og + 1u == (tg + 1u) * nx) xb_add(&bar[XB_TOPGEN], 1u);
            else XB_SPIN(xb_ld(&bar[XB_TOPGEN]) == tg, bar);
            __builtin_amdgcn_fence(__ATOMIC_ACQUIRE, "agent");
            xb_add(&bar[XB_XGEN(b.x)], 1u);
            asm volatile("s_waitcnt vmcnt(0)" ::: "memory");
        } else {
            XB_SPIN(xb_ld(&bar[XB_XGEN(b.x)]) == gen, bar);
            __builtin_amdgcn_fence(__ATOMIC_ACQUIRE, "agent");
            asm volatile("s_waitcnt vmcnt(0)" ::: "memory");
        }
    }
    __syncthreads();
}

__global__ void __launch_bounds__(NTHREADS, 2) mega_fwd(Params P) {
    extern __shared__ __attribute__((aligned(16))) unsigned char lds_raw[];
    LAS unsigned char* lds = (LAS unsigned char*)lds_raw;
    cg::grid_group grid = cg::this_grid();
    unsigned char* ws = P.ws;
    const int G = gridDim.x, bx = blockIdx.x;
    const int wid_s = __builtin_amdgcn_readfirstlane(threadIdx.x >> 6);
    float* ssq = (float*)(ws + WS_CTL + 4096);
    bf16_t* XB = (bf16_t*)(ws + WS_XB); bf16_t* HB = (bf16_t*)(ws + WS_H);

    if (threadIdx.x < 8) ((LAS unsigned*)(lds + RING_BYTES))[threadIdx.x] = 0u;
    __syncthreads();
    prologue(P, lds, wid_s);
    grid.sync();
    const XcdBarrier bar = xcd_barrier_post((unsigned*)(ws + WS_CTL) + CW_BAR, (volatile LAS unsigned*)(lds + RING_BYTES + 16));
    { pg8::Gemm g{XB, (const bf16_t*)(ws + WS_W1GU), MROWS, 2 * FFN, D_MODEL, D_MODEL / 64}; pg8::StaticOrder S; S.init(MROWS, 2 * FFN, G, bx);
      pg8::EpiSwiGLU E{HB, FFN, nullptr};
      pg8::gemm_phase<pg8::EpiSwiGLU, pg8::StaticOrder, true, true>(lds, g, S, E, wid_s); }
    if (bx >= (68 * 44) % G) cache_convert_blocks(P, lds, wid_s, 6);
    xcd_barrier(bar);
    { pg8::Gemm g{HB, (const bf16_t*)(ws + WS_W1D), MP, D_MODEL, FFN, FFN / 64}; pg8::StaticOrder S; S.init(MP, D_MODEL, G, bx);
      pg8::EpiResid E{P.in[0], P.in[1], P.out, XB, ssq, 0.5f};
      pg8::gemm_phase<pg8::EpiResid, pg8::StaticOrder, true, true>(lds, g, S, E, wid_s); }
    { pg8::Gemm g{HB, (const bf16_t*)(ws + WS_W1D), MROWS, D_MODEL, FFN, FFN / 64 / 4}; pg8::SplitOrder S; S.init(4, FFN / 64 / 4, bx);
      pg8::EpiPartial E{(float*)(ws + WS_PART)};
      pg8::gemm_phase<pg8::EpiPartial, pg8::SplitOrder, false, true>(lds, g, S, E, wid_s);
      if ((bx >> 6) >= 2) cache_convert_blocks(P, lds, wid_s, 4); }
    xcd_barrier(bar);
    finalize_sample(P, wid_s, 4, P.in[1], 0.5f, XB, ssq);
    xcd_barrier(bar);
    { pg8::Gemm g{XB, (const bf16_t*)(ws + WS_WIN), MROWS, PROJ, D_MODEL, D_MODEL / 64}; pg8::StaticOrder S; S.init(MROWS, PROJ, G, bx);
      const float* cosT = (const float*)(ws + WS_ROPE);
      pg8::EpiProj E{ssq, cosT, cosT + 4096 * 32, (bf16_t*)(ws + WS_Q), (bf16_t*)(ws + WS_KP), (bf16_t*)(ws + WS_VP), (bf16_t*)(ws + WS_KS), (bf16_t*)(ws + WS_VS), (bf16_t*)(ws + WS_CB), (bf16_t*)(ws + WS_U),
                     P.out + O_KP, P.out + O_VP, P.out + O_KS, P.out + O_VS, P.out + O_CP, P.out + O_CS};
      pg8::gemm_phase<pg8::EpiProj, pg8::StaticOrder, true, true>(lds, g, S, E, wid_s); }
    if (bx >= (68 * 24) % G) cache_convert_blocks(P, lds, wid_s, 6);
    cache_convert_blocks(P, lds, wid_s, CV_BLOCKS);
    xcd_barrier(bar);
    conv_phase(P, wid_s);
    attn_phase(P, lds, wid_s);
    xcd_barrier(bar);
    { pg8::Gemm g{(const bf16_t*)(ws + WS_A2), (const bf16_t*)(ws + WS_WOUT), MP, D_MODEL, D_MODEL, D_MODEL / 64}; pg8::StaticOrder S; S.init(MP, D_MODEL, G, bx);
      pg8::EpiResid E{P.out, P.out + (size_t)MP * D_MODEL, P.out, XB, ssq + MROWS, 1.0f};
      pg8::gemm_phase<pg8::EpiResid, pg8::StaticOrder, true, true>(lds, g, S, E, wid_s); }
    { pg8::Gemm g{(const bf16_t*)(ws + WS_A2), (const bf16_t*)(ws + WS_WOUT), MROWS, D_MODEL, D_MODEL, D_MODEL / 64 / 8}; pg8::SplitOrder S; S.init(8, D_MODEL / 64 / 8, bx);
      pg8::EpiPartial E{(float*)(ws + WS_PART)};
      pg8::gemm_phase<pg8::EpiPartial, pg8::SplitOrder, false, true>(lds, g, S, E, wid_s); }
    xcd_barrier(bar);
    finalize_sample(P, wid_s, 8, P.out + (size_t)MP * D_MODEL, 1.0f, XB, ssq + MROWS);
    xcd_barrier(bar);
    { pg8::Gemm g{XB, (const bf16_t*)(ws + WS_W2GU), MROWS, 2 * FFN, D_MODEL, D_MODEL / 64}; pg8::StaticOrder S; S.init(MROWS, 2 * FFN, G, bx);
      pg8::EpiSwiGLU E{HB, FFN, ssq + MROWS};
      pg8::gemm_phase<pg8::EpiSwiGLU, pg8::StaticOrder, true, true>(lds, g, S, E, wid_s); }
    xcd_barrier(bar);
    { pg8::Gemm g{HB, (const bf16_t*)(ws + WS_W2D), MP, D_MODEL, FFN, FFN / 64}; pg8::StaticOrder S; S.init(MP, D_MODEL, G, bx);
      pg8::EpiResid E{P.out, P.out + (size_t)MP * D_MODEL, P.out, nullptr, ssq + 2 * MROWS, 0.5f};
      pg8::gemm_phase<pg8::EpiResid, pg8::StaticOrder, true, true>(lds, g, S, E, wid_s); }
    { pg8::Gemm g{HB, (const bf16_t*)(ws + WS_W2D), MROWS, D_MODEL, FFN, FFN / 64 / 4}; pg8::SplitOrder S; S.init(4, FFN / 64 / 4, bx);
      pg8::EpiPartial E{(float*)(ws + WS_PART)};
      pg8::gemm_phase<pg8::EpiPartial, pg8::SplitOrder, false, true>(lds, g, S, E, wid_s); }
    if (G == 256) norm_own_tiles(P, wid_s);
    xcd_barrier(bar);
    final_norm_sample(P, wid_s);
    if (G != 256) { const int lane = pg8::opaque_lane(); const float* ssqc = ssq + 2 * MROWS; const float* gn = P.in[22];
        for (int m = bx * NWAVES + wid_s; m < MP; m += G * NWAVES) { float* xr = P.out + (size_t)m * D_MODEL; const float rs = __builtin_amdgcn_rsqf(ssqc[m] * (1.0f / D_MODEL) + EPS);
            for (int j = 0; j < 8; ++j) { const f32x4 v = *(const f32x4*)(xr + 256 * j + 4 * lane), gg = *(const f32x4*)(gn + 256 * j + 4 * lane); *(f32x4*)(xr + 256 * j + 4 * lane) = v * rs * gg; } } }
}

extern "C" void kernel_launch(void* const* d_in, const int* in_sizes, int n_in, void* d_out, int out_size, void* d_ws, size_t ws_size, hipStream_t stream) {
    static int grid = 0;
    if (grid == 0) {
        if (n_in != 23 || (size_t)out_size != O_END || ws_size < WS_END) { fprintf(stderr, "kernel_launch: unexpected shapes (n_in %d out %d ws %zu)\n", n_in, out_size, ws_size); grid = -1; return; }
        int dev = 0, cus = 0, per_cu = 0;
        hipGetDevice(&dev); hipDeviceGetAttribute(&cus, hipDeviceAttributeMultiprocessorCount, dev);
        if (hipFuncSetAttribute((const void*)mega_fwd, hipFuncAttributeMaxDynamicSharedMemorySize, LDS_BYTES) != hipSuccess) { fprintf(stderr, "kernel_launch: hipFuncSetAttribute failed\n"); grid = -1; return; }
        if (hipOccupancyMaxActiveBlocksPerMultiprocessor(&per_cu, (const void*)mega_fwd, NTHREADS, LDS_BYTES) != hipSuccess || per_cu < 1) { fprintf(stderr, "kernel_launch: occupancy query says %d\n", per_cu); per_cu = 1; }
        (void)hipGetLastError();
        grid = cus;
        fprintf(stderr, "kernel_launch: grid %d (per_cu %d)\n", grid, per_cu);
    }
    if (grid < 0) return;
    Params p{};
    for (int i = 0; i < 23; ++i) p.in[i] = (const float*)d_in[i];
    p.out = (float*)d_out; p.ws = (unsigned char*)d_ws;
    void* args[] = {&p};
    hipError_t e = hipLaunchCooperativeKernel((const void*)mega_fwd, dim3(grid), dim3(NTHREADS), args, LDS_BYTES, stream);
    if (e != hipSuccess) fprintf(stderr, "cooperative launch failed: %s (grid %d)\n", hipGetErrorString(e), grid);
}
```

```cpp
#include <hip/hip_runtime.h>
#include <hip/hip_cooperative_groups.h>
#include <cstdio>
#include <cstdint>
#include <cmath>
namespace cg = cooperative_groups;
namespace pg8 {
#define PG8_LAS __attribute__((address_space(3)))
typedef unsigned short bf16_t;
typedef short bf16x8 __attribute__((ext_vector_type(8)));
typedef float f32x4 __attribute__((ext_vector_type(4)));
typedef unsigned u32x4 __attribute__((ext_vector_type(4)));
constexpr int BM = 256, BK = 64, HALF = 128, HTB = HALF * BK * 2  , STAGE_BYTES = 8 * HTB, NXCD = 8, WGM = 8;

__host__ __device__ __forceinline__ int lds_byte(int r, int c) { const int st = (r >> 4) * 2 + (c >> 5), rr = r & 15, cc = c & 31, ob = rr * 64 + cc * 2; return st * 1024 + (ob ^ (((ob >> 9) & 1) << 5)); }
__host__ __device__ __forceinline__ void stage_rc(int b, int& R, int& C) { const int st = b / 1024, sb = b % 1024, swz = sb ^ (((sb >> 9) & 1) << 5); R = (st >> 1) * 16 + swz / 64; C = (st & 1) * 32 + (swz % 64) / 2; }
__host__ __device__ __forceinline__ int perm32(int rho) { const int n = rho >> 4, i = rho & 15; return 8 * (i >> 2) + 4 * n + (i & 3); }

struct Unit { int pm, pn, kt0, ks; };
struct Gemm { const bf16_t* A; const bf16_t* Bt; int M, N, K, nt; };

struct StaticOrder {
    int nM, nN, nwg, G, c;
    __host__ __device__ void init(int M, int N, int G_, int c_) { nM = M / BM; nN = N / BM; nwg = nM * nN; G = G_; c = c_; }
    __host__ __device__ bool next(int i, Unit& u) const {
        const long L = (long)i * G + c; if (L >= nwg) return false;
        int wgid = (int)L; { const int q = nwg / NXCD, r = nwg % NXCD, xcd = wgid % NXCD, off = wgid / NXCD; wgid = (xcd < r ? xcd * (q + 1) : r * (q + 1) + (xcd - r) * q) + off; }
        const int nig = WGM * nN, gid = wgid / nig, fm = gid * WGM, gsz = (nM - fm) < WGM ? (nM - fm) : WGM;
        u.pm = fm + ((wgid % nig) % gsz); u.pn = (wgid % nig) / gsz; u.kt0 = 0; u.ks = 0; return true;
    }
    __device__ __forceinline__ void a_ready(const Unit&) const {}
    __device__ __forceinline__ void done(const Unit&) const {}
};

typedef unsigned u32x2 __attribute__((ext_vector_type(2)));
typedef float f32x2_t __attribute__((ext_vector_type(2)));
typedef __bf16 bf16x2_t __attribute__((ext_vector_type(2)));
__device__ __forceinline__ unsigned cvtpk(float lo, float hi) { f32x2_t v = {lo, hi}; bf16x2_t b = __builtin_convertvector(v, bf16x2_t); return __builtin_bit_cast(unsigned, b); }
__device__ __forceinline__ u32x2 pack4(f32x4 v) { u32x2 w; w.x = cvtpk(v[0], v[1]); w.y = cvtpk(v[2], v[3]); return w; }
__device__ __forceinline__ float silu1(float g) { return g * __builtin_amdgcn_rcpf(1.0f + __builtin_amdgcn_exp2f(-1.4426950408889634f * g)); }
__device__ __forceinline__ f32x4 silu_mul(f32x4 g, f32x4 u) { f32x4 o; o[0] = silu1(g[0]) * u[0]; o[1] = silu1(g[1]) * u[1]; o[2] = silu1(g[2]) * u[2]; o[3] = silu1(g[3]) * u[3]; return o; }

__device__ __forceinline__ int opaque_lane() { int l; asm volatile("v_mbcnt_lo_u32_b32 %0, -1, 0\n\tv_mbcnt_hi_u32_b32 %0, -1, %0" : "=v"(l)); return l; }
constexpr int E_MP = 16384;
constexpr int E_DM = 2048;
constexpr float E_EPS = 1e-6f;

struct EpiSwiGLU {
    static constexpr bool PERM = true, AFTER_DRAIN = false;
    bf16_t* H; int ldh; const float* ssq;
    __device__ __forceinline__ void operator()(const f32x4 (&acc)[2][2][4][2], const Unit& u, int wr, int wc, int fr, int fq) const {
        const int row0 = u.pm * BM + wr * 64 + fr; const int col0 = u.pn * HALF + wc * 32 + 8 * fq;
#pragma unroll
        for (int ai = 0; ai < 2; ++ai)
#pragma unroll
            for (int m = 0; m < 4; ++m) { const int row = row0 + ai * HALF + m * 16;
                float rs = 1.f; if (ssq) rs = __builtin_amdgcn_rsqf(ssq[row] * (1.0f / E_DM) + E_EPS);
                const f32x4 h0 = silu_mul(acc[ai][0][m][0] * rs, acc[ai][1][m][0] * rs), h1 = silu_mul(acc[ai][0][m][1] * rs, acc[ai][1][m][1] * rs);
                u32x4 w; w.x = cvtpk(h0[0], h0[1]); w.y = cvtpk(h0[2], h0[3]); w.z = cvtpk(h1[0], h1[1]); w.w = cvtpk(h1[2], h1[3]);
                *(u32x4*)(H + (size_t)row * ldh + col0) = w; }
    }
};

struct EpiResid {
    static constexpr bool PERM = false, AFTER_DRAIN = false;
    const float* base0; const float* base1; float* out; bf16_t* xb; float* ssq; float scale;
    __device__ __forceinline__ void operator()(const f32x4 (&acc)[2][2][4][2], const Unit& u, int wr, int wc, int fr, int fq) const {
        const int row0 = u.pm * BM + wr * 64 + fr; const int col0 = u.pn * BM + wc * 32 + 4 * fq;
#pragma unroll
        for (int ai = 0; ai < 2; ++ai)
#pragma unroll
            for (int m = 0; m < 4; ++m) { const int row = row0 + ai * HALF + m * 16;
                const float* bp = (row < E_MP) ? base0 + (size_t)row * E_DM : base1 + (size_t)(row - E_MP) * E_DM;
                float* op = out + (size_t)row * E_DM; float q = 0.f;
#pragma unroll
                for (int bj = 0; bj < 2; ++bj)
#pragma unroll
                    for (int n = 0; n < 2; ++n) { const int c = col0 + bj * HALF + n * 16; const f32x4 b = *(const f32x4*)(bp + c); const f32x4 o = b + acc[ai][bj][m][n] * scale;
                        *(f32x4*)(op + c) = o; if (xb) *(u32x2*)(xb + (size_t)row * E_DM + c) = pack4(o);
                        q += (o[0] * o[0] + o[1] * o[1]) + (o[2] * o[2] + o[3] * o[3]); }
                if (ssq) { q += __shfl_xor(q, 16); q += __shfl_xor(q, 32); if (fq == 0) atomicAdd(ssq + row, q); }
                asm volatile("" ::: "memory"); }
    }
};

struct EpiProj {
    static constexpr bool PERM = false, AFTER_DRAIN = false;
    const float* ssq; const float* cosT; const float* sinT;
    bf16_t* Q; bf16_t* Kp; bf16_t* Vp; bf16_t* Ks; bf16_t* Vs; bf16_t* CB; bf16_t* U;
    float* kout_p; float* vout_p; float* kout_s; float* vout_s; float* conv_p; float* conv_s;
    __device__ __forceinline__ void operator()(const f32x4 (&acc)[2][2][4][2], const Unit& u, int wr, int wc, int fr, int fq) const {
        const int row0 = u.pm * BM + wr * 64 + fr; const int pn = u.pn;
        constexpr float C2 = 0.125f * 1.4426950408889634f;
#pragma unroll
        for (int ai = 0; ai < 2; ++ai)
#pragma unroll
            for (int m = 0; m < 4; ++m) { const int row = row0 + ai * HALF + m * 16;
                const float rs = __builtin_amdgcn_rsqf(ssq[row] * (1.0f / E_DM) + E_EPS);
                const bool samp = row >= E_MP; const int rsx = row - E_MP;
                const int pos = samp ? 2048 + (rsx & 63) : (row & 4095);
                const size_t kvrow = samp ? (size_t)((rsx >> 6) * 2112 + 2048 + (rsx & 63)) : (size_t)row;
                if (pn < 8) {
                    const int i0 = 16 * (wc & 1) + 4 * fq; const int mp = wc >> 1;
                    const f32x4 c4 = *(const f32x4*)(cosT + pos * 32 + i0), s4 = *(const f32x4*)(sinT + pos * 32 + i0);
#pragma unroll
                    for (int bj = 0; bj < 2; ++bj) { const int head = 2 * (pn & 3) + bj; const int col = head * 128 + mp * 64 + i0;
                        const f32x4 x1 = acc[ai][bj][m][0] * rs, x2 = acc[ai][bj][m][1] * rs;
                        f32x4 y1 = x1 * c4 - x2 * s4, y2 = x2 * c4 + x1 * s4;
                        if (pn < 4) { y1 = y1 * C2; y2 = y2 * C2; bf16_t* qp = Q + (size_t)row * 1024 + col; *(u32x2*)qp = pack4(y1); *(u32x2*)(qp + 32) = pack4(y2); }
                        else { float* ko = (samp ? kout_s + (size_t)rsx * 1024 : kout_p + (size_t)row * 1024) + col; __builtin_nontemporal_store(y1, (f32x4*)ko); __builtin_nontemporal_store(y2, (f32x4*)(ko + 32));
                               bf16_t* kb = (samp ? Ks : Kp) + kvrow * 1024 + col; *(u32x2*)kb = pack4(y1); *(u32x2*)(kb + 32) = pack4(y2); } }
                } else if (pn < 12) {
#pragma unroll
                    for (int bj = 0; bj < 2; ++bj)
#pragma unroll
                        for (int n = 0; n < 2; ++n) { const int col = (pn - 8) * BM + bj * HALF + wc * 32 + n * 16 + 4 * fq; const f32x4 v = acc[ai][bj][m][n] * rs;
                            float* vo = (samp ? vout_s + (size_t)rsx * 1024 : vout_p + (size_t)row * 1024) + col; __builtin_nontemporal_store(v, (f32x4*)vo);
                            *(u32x2*)((samp ? Vs : Vp) + kvrow * 1024 + col) = pack4(v); }
                } else if (pn < 16) {
#pragma unroll
                    for (int bj = 0; bj < 2; ++bj)
#pragma unroll
                        for (int n = 0; n < 2; ++n) { const int col = (pn - 12) * BM + bj * HALF + wc * 32 + n * 16 + 4 * fq; *(u32x2*)(CB + (size_t)row * 1024 + col) = pack4(acc[ai][bj][m][n] * rs); }
                } else {
                    const int t = samp ? (rsx & 63) : (row & 4095); const int tl = samp ? 62 : 4094;
#pragma unroll
                    for (int n = 0; n < 2; ++n) { const int col = (pn - 16) * HALF + wc * 32 + n * 16 + 4 * fq; const f32x4 uu = (acc[ai][0][m][n] * rs) * (acc[ai][1][m][n] * rs);
                        *(u32x2*)(U + (size_t)row * 1024 + col) = pack4(uu);
                        if (t >= tl) { float* cp = samp ? conv_s + (size_t)((rsx >> 6) * 2 + (t - tl)) * 1024 : conv_p + (size_t)((row >> 12) * 2 + (t - tl)) * 1024; *(f32x4*)(cp + col) = uu; } }
                }
                asm volatile("" ::: "memory"); }
    }
};


struct SplitOrder {
    int S, nt, c;
    __host__ __device__ void init(int S_, int nt_, int c_) { S = S_; nt = nt_; c = c_; }
    __host__ __device__ bool next(int i, Unit& u) const {
        if (i != 0) return false;
        const int xcd = c & 7, slot = c >> 3, per = (4 * S) >> 3, cl = slot >> 3;
        if (cl >= per) return false;
        const int combo = xcd * per + cl; u.pm = 64 + combo / S; u.ks = combo % S; u.kt0 = u.ks * nt; u.pn = slot & 7; return true;
    }
    __device__ __forceinline__ void a_ready(const Unit&) const {}
    __device__ __forceinline__ void done(const Unit&) const {}
};
struct EpiPartial {
    static constexpr bool PERM = false, AFTER_DRAIN = false;
    float* part;
    __device__ __forceinline__ void operator()(const f32x4 (&acc)[2][2][4][2], const Unit& u, int wr, int wc, int fr, int fq) const {
        const int row0 = (u.pm - 64) * BM + wr * 64 + fr; const int col0 = u.pn * BM + wc * 32 + 4 * fq;
        float* pb = part + (size_t)u.ks * 1024 * E_DM;
#pragma unroll
        for (int ai = 0; ai < 2; ++ai)
#pragma unroll
            for (int m = 0; m < 4; ++m) { float* op = pb + (size_t)(row0 + ai * HALF + m * 16) * E_DM + col0;
#pragma unroll
                for (int bj = 0; bj < 2; ++bj)
#pragma unroll
                    for (int n = 0; n < 2; ++n) *(f32x4*)(op + bj * HALF + n * 16) = acc[ai][bj][m][n]; }
    }
};
template <class Epi, class Sched, bool ALIGN_EPI = false, bool SP2 = false>
__device__ __forceinline__ void gemm_phase(PG8_LAS unsigned char* lds, const Gemm g, const Sched& S, const Epi& E, const int wid_in) {
    const int wid = wid_in, lane = opaque_lane(), tid = wid * 64 + lane, wr = wid >> 2, wc = wid & 3, fr = lane & 15, fq = lane >> 4;
    const int K = g.K, nt = g.nt;
    unsigned voffA[2], voffB[2];
#pragma unroll
    for (int i = 0; i < 2; ++i) { int R, C; stage_rc(tid * 16 + i * 8192, R, C); const int Rb = Epi::PERM ? ((R & ~31) + perm32(R & 31)) : R;
        voffA[i] = (unsigned)(R * K + C) * 2u; voffB[i] = (unsigned)(Rb * K + C) * 2u; }
    const size_t kstep = (size_t)(BK * 2);
    const size_t hstep = (size_t)HALF * K * 2;
    const size_t tstep = 2 * hstep;
    const unsigned ldsw = (unsigned)wid * 1024u;
    const int aoff = lds_byte(wr * 64 + fr, fq * 8), boff = lds_byte(wc * 32 + fr, fq * 8);
#define PG8_SA(b, h) (((b) * 2 + (h)) * HTB)
#define PG8_SB(b, h) ((4 + (b) * 2 + (h)) * HTB)
#define PG8_STAGE(bufoff, gbase, voff) do { _Pragma("unroll") for (int _i = 0; _i < 2; ++_i) \
        __builtin_amdgcn_global_load_lds((const unsigned*)((const char*)(gbase) + (voff)[_i]), (PG8_LAS unsigned*)(lds + (bufoff) + ldsw + _i * 8192), 16, 0, 0); } while (0)
#define PG8_LDA(dst, b, h) do { _Pragma("unroll") for (int m = 0; m < 4; ++m) _Pragma("unroll") for (int k = 0; k < 2; ++k) dst[m][k] = *(const PG8_LAS bf16x8*)(lds + PG8_SA(b, h) + aoff + m * 2048 + k * 1024); } while (0)
#define PG8_LDB(dst, b, h) do { _Pragma("unroll") for (int n = 0; n < 2; ++n) _Pragma("unroll") for (int k = 0; k < 2; ++k) dst[n][k] = *(const PG8_LAS bf16x8*)(lds + PG8_SB(b, h) + boff + n * 2048 + k * 1024); } while (0)
#define PG8_MMA(ai, bj, At, Bt) do { __builtin_amdgcn_s_setprio(1); _Pragma("unroll") for (int m = 0; m < 4; ++m) _Pragma("unroll") for (int n = 0; n < 2; ++n) _Pragma("unroll") for (int k = 0; k < 2; ++k) \
        acc[ai][bj][m][n] = __builtin_amdgcn_mfma_f32_16x16x32_bf16(Bt[n][k], At[m][k], acc[ai][bj][m][n], 0, 0, 0); __builtin_amdgcn_s_setprio(0); } while (0)
#define PG8_WAIT_V(n) asm volatile("s_waitcnt vmcnt(" #n ")" ::: "memory")
#define PG8_WAIT_L(n) asm volatile("s_waitcnt lgkmcnt(" #n ")" ::: "memory")
#define PG8_BAR __builtin_amdgcn_s_barrier()
#define PG8_SCHED __builtin_amdgcn_sched_barrier(0)
    Unit cur, nxt; int ui = 0;
    if (!S.next(0, cur)) return;
    f32x4 acc[2][2][4][2];
#pragma unroll
    for (int a = 0; a < 2; ++a)
#pragma unroll
        for (int b = 0; b < 2; ++b)
#pragma unroll
            for (int m = 0; m < 4; ++m)
#pragma unroll
                for (int n = 0; n < 2; ++n) acc[a][b][m][n] = (f32x4){0.f, 0.f, 0.f, 0.f};
    bf16x8 At[4][2], B0[2][2], B1[2][2];
    const char* cA = (const char*)g.A + (size_t)cur.pm * tstep + (size_t)cur.kt0 * kstep; const char* cB = (const char*)g.Bt + (size_t)cur.pn * tstep + (size_t)cur.kt0 * kstep;
    S.a_ready(cur);
    if constexpr (SP2) {
        PG8_STAGE(PG8_SB(0, 0), cB, voffB); PG8_STAGE(PG8_SB(0, 1), cB + hstep, voffB); PG8_STAGE(PG8_SA(0, 0), cA, voffA); PG8_STAGE(PG8_SA(0, 1), cA + hstep, voffA);
        if (wr == 1) PG8_BAR;
        PG8_WAIT_V(2); PG8_BAR;
        PG8_STAGE(PG8_SB(1, 0), cB + kstep, voffB); PG8_STAGE(PG8_SA(1, 0), cA + kstep, voffA); PG8_STAGE(PG8_SB(1, 1), cB + hstep + kstep, voffB);
        PG8_WAIT_V(6); PG8_BAR;
    } else {
        PG8_STAGE(PG8_SB(0, 0), cB, voffB); PG8_STAGE(PG8_SA(0, 0), cA, voffA); PG8_STAGE(PG8_SB(0, 1), cB + hstep, voffB); PG8_STAGE(PG8_SA(0, 1), cA + hstep, voffA);
        if (wr == 1) PG8_BAR;
        PG8_WAIT_V(4); PG8_BAR;
        PG8_STAGE(PG8_SB(1, 0), cB + kstep, voffB); PG8_STAGE(PG8_SA(1, 0), cA + kstep, voffA); PG8_STAGE(PG8_SB(1, 1), cB + hstep + kstep, voffB);
        PG8_WAIT_V(6); PG8_BAR;
    }
    for (;;) {
        const bool has_next = S.next(ui + 1, nxt);
        const char* nA = has_next ? (const char*)g.A + (size_t)nxt.pm * tstep + (size_t)nxt.kt0 * kstep : cA; const char* nB = has_next ? (const char*)g.Bt + (size_t)nxt.pn * tstep + (size_t)nxt.kt0 * kstep : cB;
        for (int t = 0; t < nt; t += 2) {
            const bool last = (t == nt - 2);
            const char* a1 = cA + (size_t)(t + 1) * kstep;
            const char* a2 = last ? nA : cA + (size_t)(t + 2) * kstep; const char* b2 = last ? nB : cB + (size_t)(t + 2) * kstep;
            const char* a3 = a2 + kstep; const char* b3 = b2 + kstep;
            if (last && has_next) S.a_ready(nxt);
            if constexpr (SP2) {
            PG8_LDB(B0, 0, 0); PG8_LDB(B1, 0, 1); PG8_SCHED; PG8_LDA(At, 0, 0); PG8_STAGE(PG8_SA(1, 1), a1 + hstep, voffA);
            PG8_WAIT_V(8); PG8_WAIT_L(0); PG8_BAR; PG8_MMA(0, 0, At, B0); PG8_MMA(0, 1, At, B1); PG8_BAR; PG8_SCHED;
            PG8_LDA(At, 0, 1); PG8_STAGE(PG8_SB(0, 0), b2, voffB); PG8_STAGE(PG8_SB(0, 1), b2 + hstep, voffB); PG8_STAGE(PG8_SA(0, 0), a2, voffA);
            PG8_WAIT_V(8); PG8_WAIT_L(0); PG8_BAR; PG8_MMA(1, 0, At, B0); PG8_MMA(1, 1, At, B1); PG8_BAR; PG8_SCHED;
            PG8_LDB(B0, 1, 0); PG8_LDB(B1, 1, 1); PG8_SCHED; PG8_LDA(At, 1, 0); PG8_STAGE(PG8_SA(0, 1), a2 + hstep, voffA);
            PG8_WAIT_V(8); PG8_WAIT_L(0); PG8_BAR; PG8_MMA(0, 0, At, B0); PG8_MMA(0, 1, At, B1); PG8_BAR; PG8_SCHED;
            PG8_LDA(At, 1, 1); PG8_STAGE(PG8_SB(1, 0), b3, voffB); PG8_STAGE(PG8_SB(1, 1), b3 + hstep, voffB); PG8_STAGE(PG8_SA(1, 0), a3, voffA);
            PG8_WAIT_V(8); PG8_WAIT_L(0); PG8_BAR; PG8_MMA(1, 0, At, B0); PG8_MMA(1, 1, At, B1); PG8_BAR; PG8_SCHED;
            } else {
            PG8_LDB(B0, 0, 0); PG8_SCHED; PG8_LDA(At, 0, 0); PG8_STAGE(PG8_SA(1, 1), a1 + hstep, voffA);
            PG8_WAIT_L(8); PG8_BAR; PG8_WAIT_L(0); PG8_MMA(0, 0, At, B0); PG8_BAR; PG8_SCHED;
            PG8_LDB(B1, 0, 1); PG8_STAGE(PG8_SB(0, 0), b2, voffB);
            PG8_BAR; PG8_WAIT_L(0); PG8_MMA(0, 1, At, B1); PG8_BAR;
            PG8_LDA(At, 0, 1); PG8_STAGE(PG8_SA(0, 0), a2, voffA);
            PG8_BAR; PG8_WAIT_L(0); PG8_MMA(1, 0, At, B0); PG8_BAR; PG8_SCHED;
            PG8_STAGE(PG8_SB(0, 1), b2 + hstep, voffB);
            PG8_WAIT_V(6); PG8_BAR; PG8_MMA(1, 1, At, B1); PG8_BAR;
            PG8_LDB(B0, 1, 0); PG8_SCHED; PG8_LDA(At, 1, 0); PG8_STAGE(PG8_SA(0, 1), a2 + hstep, voffA);
            PG8_WAIT_L(8); PG8_BAR; PG8_WAIT_L(0); PG8_MMA(0, 0, At, B0); PG8_BAR; PG8_SCHED;
            PG8_LDB(B1, 1, 1); PG8_STAGE(PG8_SB(1, 0), b3, voffB);
            PG8_BAR; PG8_WAIT_L(0); PG8_MMA(0, 1, At, B1); PG8_BAR;
            PG8_LDA(At, 1, 1); PG8_STAGE(PG8_SA(1, 0), a3, voffA);
            PG8_BAR; PG8_WAIT_L(0); PG8_MMA(1, 0, At, B0); PG8_BAR; PG8_SCHED;
            PG8_STAGE(PG8_SB(1, 1), b3 + hstep, voffB);
            PG8_WAIT_V(6); PG8_BAR; PG8_MMA(1, 1, At, B1); PG8_BAR;
            }
        }
        if constexpr (ALIGN_EPI) { if (wr == 0) PG8_BAR; }
        if constexpr (!Epi::AFTER_DRAIN) { E(acc, cur, wr, wc, fr, fq); S.done(cur); }
        if (!has_next) break;
#pragma unroll
        for (int a = 0; a < 2; ++a)
#pragma unroll
            for (int b = 0; b < 2; ++b)
#pragma unroll
                for (int m = 0; m < 4; ++m)
#pragma unroll
                    for (int n = 0; n < 2; ++n) acc[a][b][m][n] = (f32x4){0.f, 0.f, 0.f, 0.f};
        cur = nxt; cA = nA; cB = nB; ++ui;
        if constexpr (ALIGN_EPI) { if (wr == 1) PG8_BAR; }
    }
    PG8_WAIT_V(0);
    if constexpr (!ALIGN_EPI) { if (wr == 0) PG8_BAR; }
    PG8_BAR;
    if constexpr (Epi::AFTER_DRAIN) { E.fused(acc, cur, wr, wc, fr, fq, lds, wid, lane); S.done(cur); }
#undef PG8_SA
#undef PG8_SB
#undef PG8_STAGE
#undef PG8_LDA
#undef PG8_LDB
#undef PG8_MMA
#undef PG8_WAIT_V
#undef PG8_WAIT_L
#undef PG8_BAR
#undef PG8_SCHED
}
}

#define LAS __attribute__((address_space(3)))
typedef unsigned short bf16_t;
typedef short bf16x8 __attribute__((ext_vector_type(8)));
typedef short s16x4 __attribute__((ext_vector_type(4)));
typedef float f32x4 __attribute__((ext_vector_type(4)));
typedef float f32x16 __attribute__((ext_vector_type(16)));
typedef unsigned u32x4 __attribute__((ext_vector_type(4)));
typedef unsigned u32x2 __attribute__((ext_vector_type(2)));
using pg8::cvtpk;

constexpr int NWAVES = 8, NTHREADS = 512;
constexpr int D_MODEL = 2048, FFN = 5632, PROJ = 6144;
constexpr int MP = 16384, MS = 1024, MROWS = MP + MS;
constexpr int SEQ = 4096, DSEQ = 64, PAST = 2048, SKV = PAST + DSEQ;
constexpr float EPS = 1e-6f;
constexpr float LAMBDA_INIT = 0.2f;

constexpr size_t MiB = 1u << 20;
constexpr size_t WS_CTL = 0;
constexpr size_t WS_ROPE = 1 * MiB;
constexpr size_t WS_W1GU = 2 * MiB, WS_W1D = 46 * MiB, WS_WIN = 68 * MiB, WS_WOUT = 92 * MiB, WS_W2GU = 100 * MiB, WS_W2D = 144 * MiB;
constexpr size_t WS_XB = 166 * MiB;
constexpr size_t WS_H = 234 * MiB;
constexpr size_t WS_Q = 234 * MiB, WS_U = 268 * MiB, WS_CB = 302 * MiB, WS_A2 = 336 * MiB;
constexpr size_t WS_KP = 421 * MiB, WS_VP = 453 * MiB, WS_KS = 485 * MiB, WS_VS = 551 * MiB, WS_PART = 617 * MiB, WS_END = 681 * MiB;
static_assert(WS_A2 + (size_t)MROWS * 2048 * 2 <= WS_KP && WS_H + (size_t)MROWS * FFN * 2 <= WS_KP, "ws map");

constexpr size_t O_Y = 0, O_KP = 35651584, O_VP = 52428800, O_CP = 69206016, O_KS = 69214208, O_VS = 70262784, O_CS = 71311360, O_END = 71344128;

constexpr int RING_BYTES = 147456, LDS_BYTES = RING_BYTES + 1024;
constexpr int CW_BAR = 131072;
constexpr int XCD_BAR_WORDS_C = 3456;

struct Params { const float* in[23]; float* out; unsigned char* ws; };

__device__ __forceinline__ float wave_sum(float v) {
#pragma unroll
    for (int o = 1; o < 64; o <<= 1) v += __shfl_xor(v, o);
    return v;
}

__device__ __forceinline__ void transpose_item(const float* W, int ldw, int coff, int K, const float* gain, bf16_t* WT, int dbase, int hstride, int dadd, bool swp,
                                               LAS float* scr, int kb, int nb, int lane) {
    const int k0 = 64 * kb, n0 = 32 * nb;
    { f32x4 w[8]; const int c4 = 4 * (lane & 7);
#pragma unroll
      for (int i = 0; i < 8; ++i) w[i] = __builtin_nontemporal_load((const f32x4*)(W + (size_t)(k0 + 8 * i + (lane >> 3)) * ldw + coff + n0 + c4));
#pragma unroll
      for (int i = 0; i < 8; ++i) { const int kk = 8 * i + (lane >> 3); const float gg = gain ? gain[k0 + kk] : 1.0f; LAS float* d = scr + kk * 33 + c4;
          d[0] = w[i][0] * gg; d[1] = w[i][1] * gg; d[2] = w[i][2] * gg; d[3] = w[i][3] * gg; } }
    asm volatile("s_waitcnt lgkmcnt(0)" ::: "memory");
    const int c = lane & 7;
#pragma unroll
    for (int j = 0; j < 4; ++j) { const int n = (lane >> 3) + 8 * j; const LAS float* s = scr + (8 * c) * 33 + n;
        u32x4 o; o.x = cvtpk(s[0 * 33], s[1 * 33]); o.y = cvtpk(s[2 * 33], s[3 * 33]); o.z = cvtpk(s[4 * 33], s[5 * 33]); o.w = cvtpk(s[6 * 33], s[7 * 33]);
        const int col = n0 + n; int low = col & 127; if (swp) low = (low & ~48) | ((low & 16) << 1) | ((low & 32) >> 1);
        const int drow = dbase + (col >> 7) * hstride + dadd + low;
        *(u32x4*)(WT + (size_t)drow * K + k0 + 8 * c) = o; }
    asm volatile("s_waitcnt lgkmcnt(0)" ::: "memory");
}

__device__ __forceinline__ void prologue(const Params& P, LAS unsigned char* lds, const int wid_in) {
    const int wave = wid_in, lane = pg8::opaque_lane(), tid = wave * 64 + lane;
    const int gw = blockIdx.x * NWAVES + wave, NGW = gridDim.x * NWAVES;
    const int gt = blockIdx.x * NTHREADS + tid, NGT = gridDim.x * NTHREADS;
    unsigned char* ws = P.ws;
    { unsigned* ctl = (unsigned*)(ws + WS_CTL); if (gt < 9) ctl[64 * gt] = 0u; if (gt < 64) ctl[65536 + 16 * gt] = 0u; for (int i = gt; i < XCD_BAR_WORDS_C; i += NGT) ctl[CW_BAR + i] = 0u; float* ssq = (float*)(ws + WS_CTL + 4096); for (int i = gt; i < 3 * MROWS; i += NGT) ssq[i] = 0.f; }
    { float* cosT = (float*)(ws + WS_ROPE); float* sinT = cosT + 4096 * 32;
      for (int e = gt; e < 4096 * 32; e += NGT) { const int pos = e >> 5, i = e & 31;
          const float inv = exp2f(-(float)i * 0.41524101186092029f);
          const float ang = (float)pos * inv;
          double r = (double)ang; r -= 6.283185307179586477 * rint(r * 0.15915494309189533577);
          const double r2 = r * r;
          double s = -1.0 / 25852016738884976640000.0;
          s = s * r2 + 1.0 / 51090942171709440000.0;
          s = s * r2 - 1.0 / 121645100408832000.0;
          s = s * r2 + 1.0 / 355687428096000.0;
          s = s * r2 - 1.0 / 1307674368000.0;
          s = s * r2 + 1.0 / 6227020800.0;
          s = s * r2 - 1.0 / 39916800.0;
          s = s * r2 + 1.0 / 362880.0;
          s = s * r2 - 1.0 / 5040.0;
          s = s * r2 + 1.0 / 120.0;
          s = s * r2 - 1.0 / 6.0;
          s = s * r2 + 1.0; s *= r;
          double c = 1.0 / 1124000727777607680000.0;
          c = c * r2 - 1.0 / 2432902008176640000.0;
          c = c * r2 + 1.0 / 6402373705728000.0;
          c = c * r2 - 1.0 / 20922789888000.0;
          c = c * r2 + 1.0 / 87178291200.0;
          c = c * r2 - 1.0 / 479001600.0;
          c = c * r2 + 1.0 / 3628800.0;
          c = c * r2 - 1.0 / 40320.0;
          c = c * r2 + 1.0 / 720.0;
          c = c * r2 - 1.0 / 24.0;
          c = c * r2 + 0.5; c = 1.0 - c * r2;
          cosT[e] = (float)c; sinT[e] = (float)s; } }
    { LAS float* scr = (LAS float*)(lds + wave * 16384);
      constexpr int I_GU = (D_MODEL / 64) * (FFN / 32), I_D = (FFN / 64) * (D_MODEL / 32), I_S = (D_MODEL / 64) * (1024 / 32), I_O = (D_MODEL / 64) * (D_MODEL / 32);
      constexpr int NITEMS = 4 * I_GU + 2 * I_D + 6 * I_S + I_O;
      bf16_t* W1GU = (bf16_t*)(ws + WS_W1GU); bf16_t* W1D = (bf16_t*)(ws + WS_W1D); bf16_t* WIN = (bf16_t*)(ws + WS_WIN); bf16_t* WOUT = (bf16_t*)(ws + WS_WOUT);
      bf16_t* W2GU = (bf16_t*)(ws + WS_W2GU); bf16_t* W2D = (bf16_t*)(ws + WS_W2D);
      for (int it = gw; it < NITEMS; it += NGW) { int r = it;
          if (r < I_GU) { transpose_item(P.in[6], FFN, 0, D_MODEL, P.in[5], W1GU, 0, 256, 0, false, scr, r / (FFN / 32), r % (FFN / 32), lane); continue; } r -= I_GU;
          if (r < I_GU) { transpose_item(P.in[7], FFN, 0, D_MODEL, P.in[5], W1GU, 0, 256, 128, false, scr, r / (FFN / 32), r % (FFN / 32), lane); continue; } r -= I_GU;
          if (r < I_GU) { transpose_item(P.in[19], FFN, 0, D_MODEL, P.in[18], W2GU, 0, 256, 0, false, scr, r / (FFN / 32), r % (FFN / 32), lane); continue; } r -= I_GU;
          if (r < I_GU) { transpose_item(P.in[20], FFN, 0, D_MODEL, P.in[18], W2GU, 0, 256, 128, false, scr, r / (FFN / 32), r % (FFN / 32), lane); continue; } r -= I_GU;
          if (r < I_D) { transpose_item(P.in[8], D_MODEL, 0, FFN, nullptr, W1D, 0, 128, 0, false, scr, r / (D_MODEL / 32), r % (D_MODEL / 32), lane); continue; } r -= I_D;
          if (r < I_D) { transpose_item(P.in[21], D_MODEL, 0, FFN, nullptr, W2D, 0, 128, 0, false, scr, r / (D_MODEL / 32), r % (D_MODEL / 32), lane); continue; } r -= I_D;
          if (r < I_S) { transpose_item(P.in[10], PROJ, 0, D_MODEL, P.in[9], WIN, 0, 128, 0, true, scr, r / 32, r % 32, lane); continue; } r -= I_S;
          if (r < I_S) { transpose_item(P.in[10], PROJ, 1024, D_MODEL, P.in[9], WIN, 1024, 128, 0, true, scr, r / 32, r % 32, lane); continue; } r -= I_S;
          if (r < I_S) { transpose_item(P.in[10], PROJ, 2048, D_MODEL, P.in[9], WIN, 2048, 128, 0, false, scr, r / 32, r % 32, lane); continue; } r -= I_S;
          if (r < I_S) { transpose_item(P.in[10], PROJ, 3072, D_MODEL, P.in[9], WIN, 3072, 128, 0, false, scr, r / 32, r % 32, lane); continue; } r -= I_S;
          if (r < I_S) { transpose_item(P.in[10], PROJ, 4096, D_MODEL, P.in[9], WIN, 4096, 256, 0, false, scr, r / 32, r % 32, lane); continue; } r -= I_S;
          if (r < I_S) { transpose_item(P.in[10], PROJ, 5120, D_MODEL, P.in[9], WIN, 4096, 256, 128, false, scr, r / 32, r % 32, lane); continue; } r -= I_S;
          transpose_item(P.in[17], D_MODEL, 0, D_MODEL, nullptr, WOUT, 0, 128, 0, false, scr, r / (D_MODEL / 32), r % (D_MODEL / 32), lane);
      } }
    { bf16_t* XB = (bf16_t*)(ws + WS_XB);
      for (int m = gw; m < MROWS; m += NGW) { const float* xr = (m < MP) ? P.in[0] + (size_t)m * D_MODEL : P.in[1] + (size_t)(m - MP) * D_MODEL;
          f32x4 v[8]; float s = 0.f;
#pragma unroll
          for (int j = 0; j < 8; ++j) { v[j] = __builtin_nontemporal_load((const f32x4*)(xr + 256 * j + 4 * lane)); s += (v[j][0] * v[j][0] + v[j][1] * v[j][1]) + (v[j][2] * v[j][2] + v[j][3] * v[j][3]); }
          const float rs = __builtin_amdgcn_rsqf(wave_sum(s) * (1.0f / D_MODEL) + EPS);
#pragma unroll
          for (int j = 0; j < 8; ++j) *(u32x2*)(XB + (size_t)m * D_MODEL + 256 * j + 4 * lane) = pg8::pack4(v[j] * rs); } }
}

constexpr int CV_BLOCKS = 2 * 16 * PAST * 1024 / 32768;
__device__ __forceinline__ void cache_convert_blocks(const Params& P, LAS unsigned char* lds, const int wid_in, int max_blocks) {
    const int lane = pg8::opaque_lane(), tid = wid_in * 64 + lane;
    unsigned* counter = (unsigned*)(P.ws + WS_CTL) + 64 * 8;
    LAS unsigned* slot = (LAS unsigned*)(lds + RING_BYTES + 8);
    bf16_t* KS = (bf16_t*)(P.ws + WS_KS); bf16_t* VS = (bf16_t*)(P.ws + WS_VS);
    for (int n = 0; n < max_blocks; ++n) {
        __syncthreads();
        if (tid == 0) *slot = atomicAdd(counter, 1u);
        __syncthreads();
        const int blk = (int)*slot;
        if (blk >= CV_BLOCKS) break;
        const int which = blk >= CV_BLOCKS / 2; const size_t el0 = (size_t)(which ? blk - CV_BLOCKS / 2 : blk) * 32768;
        const float* src = (which ? P.in[3] : P.in[2]) + el0; bf16_t* dst = which ? VS : KS;
#pragma unroll
        for (int half = 0; half < 2; ++half) { f32x4 a[4], c[4];
#pragma unroll
            for (int k = 0; k < 4; ++k) { const float* sp = src + (size_t)((half * 4 + k) * NTHREADS + tid) * 8; a[k] = __builtin_nontemporal_load((const f32x4*)sp); c[k] = __builtin_nontemporal_load((const f32x4*)(sp + 4)); }
#pragma unroll
            for (int k = 0; k < 4; ++k) { const size_t el = el0 + (size_t)((half * 4 + k) * NTHREADS + tid) * 8; const int b = (int)(el >> 21); const size_t rem = el & ((1u << 21) - 1);
                u32x4 w; w.x = cvtpk(a[k][0], a[k][1]); w.y = cvtpk(a[k][2], a[k][3]); w.z = cvtpk(c[k][0], c[k][1]); w.w = cvtpk(c[k][2], c[k][3]);
                *(u32x4*)(dst + (size_t)b * SKV * 1024 + rem) = w; } }
    }
}

__device__ __forceinline__ void bf8_to_f32(u32x4 w, float (&f)[8]) {
#pragma unroll
    for (int i = 0; i < 4; ++i) { f[2 * i] = __uint_as_float(w[i] << 16); f[2 * i + 1] = __uint_as_float(w[i] & 0xffff0000u); }
}
__device__ __forceinline__ void conv_phase(const Params& P, const int wid_in) {
    const int wave = wid_in, lane = pg8::opaque_lane();
    const int gw = blockIdx.x * NWAVES + wave, NGW = gridDim.x * NWAVES;
    const bf16_t* U = (const bf16_t*)(P.ws + WS_U); const bf16_t* CB = (const bf16_t*)(P.ws + WS_CB); bf16_t* A2 = (bf16_t*)(P.ws + WS_A2);
    const float* cw = P.in[16]; const float* st = P.in[4];
    for (int it = gw; it < (MROWS / 8) * 2; it += NGW) { const int row0 = (it >> 1) * 8, c0 = (it & 1) * 512 + lane * 8;
        const bool samp = row0 >= MP; const int rsx0 = row0 - MP; const int t0 = samp ? (rsx0 & 63) : (row0 & 4095); const int b = rsx0 >> 6;
        u32x4 ur[8], cr[8], hr0, hr1; f32x4 sa0, sc0, sa1, sc1;
#pragma unroll
        for (int i = 0; i < 8; ++i) { ur[i] = *(const u32x4*)(U + (size_t)(row0 + i) * 1024 + c0); cr[i] = *(const u32x4*)(CB + (size_t)(row0 + i) * 1024 + c0); }
        float p2[8], p1[8], w0[8], w1[8], w2[8];
        if (t0 > 0) { hr0 = *(const u32x4*)(U + (size_t)(row0 - 2) * 1024 + c0); hr1 = *(const u32x4*)(U + (size_t)(row0 - 1) * 1024 + c0); bf8_to_f32(hr0, p2); bf8_to_f32(hr1, p1); }
        else if (samp) { const float* sp = st + (size_t)(b * 2) * 1024 + c0; sa0 = *(const f32x4*)sp; sc0 = *(const f32x4*)(sp + 4); sa1 = *(const f32x4*)(sp + 1024); sc1 = *(const f32x4*)(sp + 1028);
#pragma unroll
            for (int i = 0; i < 4; ++i) { p2[i] = sa0[i]; p2[4 + i] = sc0[i]; p1[i] = sa1[i]; p1[4 + i] = sc1[i]; } }
        else {
#pragma unroll
            for (int i = 0; i < 8; ++i) { p2[i] = 0.f; p1[i] = 0.f; } }
        { const f32x4 a = *(const f32x4*)(cw + c0), c = *(const f32x4*)(cw + c0 + 4); for (int i = 0; i < 4; ++i) { w0[i] = a[i]; w0[4 + i] = c[i]; } }
        { const f32x4 a = *(const f32x4*)(cw + 1024 + c0), c = *(const f32x4*)(cw + 1024 + c0 + 4); for (int i = 0; i < 4; ++i) { w1[i] = a[i]; w1[4 + i] = c[i]; } }
        { const f32x4 a = *(const f32x4*)(cw + 2048 + c0), c = *(const f32x4*)(cw + 2048 + c0 + 4); for (int i = 0; i < 4; ++i) { w2[i] = a[i]; w2[4 + i] = c[i]; } }
#pragma unroll
        for (int r = 0; r < 8; ++r) { float cur[8], cb[8], o[8]; bf8_to_f32(ur[r], cur); bf8_to_f32(cr[r], cb);
#pragma unroll
            for (int i = 0; i < 8; ++i) { o[i] = cb[i] * (w0[i] * p2[i] + w1[i] * p1[i] + w2[i] * cur[i]); p2[i] = p1[i]; p1[i] = cur[i]; }
            u32x4 w; w.x = cvtpk(o[0], o[1]); w.y = cvtpk(o[2], o[3]); w.z = cvtpk(o[4], o[5]); w.w = cvtpk(o[6], o[7]);
            *(u32x4*)(A2 + (size_t)(row0 + r) * 2048 + 1024 + c0) = w; } }
}

constexpr int NUNITS = 1024 + 64;
__device__ __forceinline__ s16x4 tr16(const LAS unsigned char* p) {
    typedef short v4i16_t __attribute__((ext_vector_type(4)));
    return __builtin_bit_cast(s16x4, __builtin_amdgcn_ds_read_tr16_b64_v4i16((LAS v4i16_t*)p));
}
__device__ __forceinline__ void glds16(const void* gsrc, unsigned lds_dst) { unsigned keep;
    asm volatile("s_mov_b32 %0, m0\n\ts_mov_b32 m0, %2\n\ts_nop 0\n\tglobal_load_lds_dwordx4 %1, off\n\ts_mov_b32 m0, %0" : "=&s"(keep) : "v"(gsrc), "s"(lds_dst) : "memory"); }
__device__ __forceinline__ float max3f(float a, float b, float c) { float r; asm("v_max3_f32 %0, %1, %2, %3" : "=v"(r) : "v"(a), "v"(b), "v"(c)); return r; }
__device__ __forceinline__ void attn_phase(const Params& P, LAS unsigned char* lds, const int wid_in) {
    const int wid = wid_in, lane = pg8::opaque_lane(), tid = wid * 64 + lane;
    const int g = wid >> 2, rg = wid & 3;
    const int l32 = lane & 31, hi = lane >> 5;
    const bf16_t* Q = (const bf16_t*)(P.ws + WS_Q); bf16_t* A2 = (bf16_t*)(P.ws + WS_A2);
    unsigned* counter = (unsigned*)(P.ws + WS_CTL);
    LAS unsigned* qslot = (LAS unsigned*)(lds + RING_BYTES);
    float lam;
    { const float a = P.in[11][lane] * P.in[12][lane], b = P.in[13][lane] * P.in[14][lane]; lam = __expf(wave_sum(a)) - __expf(wave_sum(b)) + LAMBDA_INIT; }
    const int r2 = lane >> 4, pc = lane & 15;
    const unsigned lds0 = (unsigned)(uintptr_t)lds;
    unsigned koffv[2], voffv[2];
#pragma unroll
    for (int i = 0; i < 2; ++i) { const int row = 8 * wid + 4 * i + r2; koffv[i] = (unsigned)(row * 2048 + 16 * (pc ^ (row & 15))); voffv[i] = (unsigned)(row * 2048 + 16 * (pc ^ (((row & 3) << 2) | ((row >> 2) & 3)))); }
    unsigned kro[4];
#pragma unroll
    for (int d0 = 0; d0 < 4; ++d0) { const int ch = 8 * g + 2 * d0 + hi; kro[d0] = (unsigned)(l32 * 256 + 16 * (ch ^ (l32 & 15))); }
    const int i16 = lane & 15, q_ = i16 >> 2, p_ = i16 & 3, gcol = (lane >> 4) & 1;
    unsigned vro[4][2];
#pragma unroll
    for (int blk = 0; blk < 4; ++blk)
#pragma unroll
        for (int sec = 0; sec < 2; ++sec) { const int row = 4 * hi + 8 * sec + q_; const int c = 4 * blk + 2 * gcol + (p_ >> 1); const int swz = ((row & 3) << 2) | ((row >> 2) & 3);
            vro[blk][sec] = (unsigned)(256 * row + 16 * (c ^ swz) + 8 * (p_ & 1)); }
    int myq = (int)(__builtin_amdgcn_s_getreg((3 << 11) | 20) & 7u), tries = 0;
    if (g == 1) __builtin_amdgcn_s_setprio(1);
    for (;;) {
        __syncthreads();
        if (tid == 0) *qslot = atomicAdd(counter + 64 * myq, 1u);
        __syncthreads();
        const int ui = (int)*qslot;
        if (ui >= 144) { if (++tries == 8) break; myq = (myq + 1) & 7; continue; }
        int b, head, NT, NTw, qrow0; const bf16_t* Kb; const bf16_t* Vb;
        if (ui >= 60 && ui < 76) { const int s = 16 * myq + (ui - 60); b = s >> 3; head = s & 7; NT = 33; NTw = (rg < 2) ? 33 : 0; qrow0 = MP + 64 * b;
            Kb = (const bf16_t*)(P.ws + WS_KS) + (size_t)b * SKV * 1024; Vb = (const bf16_t*)(P.ws + WS_VS) + (size_t)b * SKV * 1024; }
        else { int cp, pr; if (ui < 60) { cp = 31 - (ui >> 2); pr = 4 * myq + (ui & 3); } else { const int v = ui - 76; cp = 16 - (v >> 2); pr = 4 * myq + (v & 3); }
            b = pr >> 3; head = pr & 7; NT = 2 * cp + 2; NTw = NT - ((rg < 2) ? 1 : 0); qrow0 = b * SEQ + 128 * cp;
            Kb = (const bf16_t*)(P.ws + WS_KP) + (size_t)b * SEQ * 1024; Vb = (const bf16_t*)(P.ws + WS_VP) + (size_t)b * SEQ * 1024; }
        const char* kgb = (const char*)Kb + head * 256; const char* vgb = (const char*)Vb + head * 256;
#define AT_DMA(k) do { const int k_ = (k); const unsigned lk_ = lds0 + (unsigned)((k_ & 3) * 16384 + wid * 2048), lv_ = lds0 + 65536u + (unsigned)((k_ % 5) * 16384 + wid * 2048); const size_t to_ = (size_t)k_ * 131072; _Pragma("unroll") for (int i = 0; i < 2; ++i) { \
            glds16(kgb + to_ + koffv[i], (unsigned)__builtin_amdgcn_readfirstlane(lk_ + i * 1024)); glds16(vgb + to_ + voffv[i], (unsigned)__builtin_amdgcn_readfirstlane(lv_ + i * 1024)); } } while (0)
        AT_DMA(0); AT_DMA(1);
        bf16x8 qf[4];
        { int qrow = qrow0 + 32 * rg + l32; qrow = qrow < MROWS ? qrow : MROWS - 1;
          const bf16_t* qp = Q + (size_t)qrow * 1024 + head * 128 + g * 64 + hi * 8;
#pragma unroll
          for (int d0 = 0; d0 < 4; ++d0) qf[d0] = *(const bf16x8*)(qp + 16 * d0); }
        asm volatile("" : "+v"(qf[0]), "+v"(qf[1]), "+v"(qf[2]), "+v"(qf[3]));
        asm volatile("s_waitcnt vmcnt(0) lgkmcnt(0)" ::: "memory"); __builtin_amdgcn_s_barrier(); asm volatile("" ::: "memory");
        f32x16 o[4];
#pragma unroll
        for (int blk = 0; blk < 4; ++blk)
#pragma unroll
            for (int r = 0; r < 16; ++r) o[blk][r] = 0.f;
        f32x16 negm;
#pragma unroll
        for (int r = 0; r < 16; ++r) negm[r] = 0.f;
        asm volatile("" : "+v"(negm));
        float mref = 0.f, lrun = 0.f;
        bf16x8 pb[2];
#pragma unroll
        for (int i = 0; i < 2; ++i) pb[i] = (bf16x8){0, 0, 0, 0, 0, 0, 0, 0};
        f32x16 p1k;
#pragma unroll
        for (int r = 0; r < 16; ++r) p1k[r] = 0.f;
        for (int h = 0; h < 2 * NT + 1; ++h) {
          if ((h & 3) == 0) { const int j2 = (h >> 1) + 2; if (j2 < NT) AT_DMA(j2); if (j2 + 1 < NT) AT_DMA(j2 + 1); }
          const int t2 = h - g;
          if (t2 >= 0 && t2 < 2 * NTw) {
            const int t = t2 >> 1;
            const LAS unsigned char* bb = lds + (t & 3) * 16384;
            const LAS unsigned char* bv = lds + 65536 + (t % 5) * 16384;
            if ((t2 & 1) == 0) {
            f32x16 p0, p1;
            bf16x8 kf[8];
#pragma unroll
            for (int d0 = 0; d0 < 4; ++d0) { kf[2 * d0] = *(const LAS bf16x8*)(bb + kro[d0]); kf[2 * d0 + 1] = *(const LAS bf16x8*)(bb + kro[d0] + 8192); }
            asm volatile("" : "+v"(kf[0]), "+v"(kf[1]), "+v"(kf[2]), "+v"(kf[3]), "+v"(kf[4]), "+v"(kf[5]), "+v"(kf[6]), "+v"(kf[7]));
            p0 = __builtin_amdgcn_mfma_f32_32x32x16_bf16(kf[0], qf[0], negm, 0, 0, 0); p1 = __builtin_amdgcn_mfma_f32_32x32x16_bf16(kf[1], qf[0], negm, 0, 0, 0);
#pragma unroll
            for (int d0 = 1; d0 < 4; ++d0) { p0 = __builtin_amdgcn_mfma_f32_32x32x16_bf16(kf[2 * d0], qf[d0], p0, 0, 0, 0); p1 = __builtin_amdgcn_mfma_f32_32x32x16_bf16(kf[2 * d0 + 1], qf[d0], p1, 0, 0, 0); }
            asm volatile("s_nop 15\n\ts_nop 7" : "+v"(p0), "+v"(p1));
            float mx;
            { float a = max3f(p0[0], p0[1], p1[0]), b2 = max3f(p0[2], p0[3], p1[1]); a = max3f(a, p1[2], p1[3]);
#pragma unroll
              for (int r = 4; r < 16; r += 4) { a = max3f(a, p0[r], p0[r + 1]); b2 = max3f(b2, p0[r + 2], p0[r + 3]); a = max3f(a, p1[r], p1[r + 1]); b2 = max3f(b2, p1[r + 2], p1[r + 3]); }
              mx = max3f(a, b2, b2);
              auto rr = __builtin_amdgcn_permlane32_swap(__float_as_uint(mx), __float_as_uint(mx), false, false); mx = max3f(__uint_as_float(rr[0]), __uint_as_float(rr[1]), __uint_as_float(rr[1])); }
            if (t == 0 || __builtin_amdgcn_ballot_w64(mx > 8.0f) != 0ull) {
                const float dl = (t == 0) ? mx : fmaxf(mx, 0.f);
                mref += dl;
#pragma unroll
                for (int r = 0; r < 16; ++r) { p0[r] -= dl; p1[r] -= dl; }
#pragma unroll
                for (int r = 0; r < 16; ++r) negm[r] = -mref;
                asm volatile("" : "+v"(negm));
                if (t != 0) { const float f = __builtin_amdgcn_exp2f(-dl); lrun *= f;
#pragma unroll
                    for (int blk = 0; blk < 4; ++blk)
#pragma unroll
                        for (int r = 0; r < 16; ++r) o[blk][r] *= f; }
            }
            float ls0 = 0.f, ls2 = 0.f;
#pragma unroll
            for (int r = 0; r < 16; r += 2) { p0[r] = __builtin_amdgcn_exp2f(p0[r]); p0[r + 1] = __builtin_amdgcn_exp2f(p0[r + 1]); ls0 += p0[r]; ls2 += p0[r + 1]; }
            lrun += ls0 + ls2;
            { u32x4 w;
              w.x = cvtpk(p0[0], p0[1]); w.y = cvtpk(p0[2], p0[3]); w.z = cvtpk(p0[4], p0[5]); w.w = cvtpk(p0[6], p0[7]); pb[0] = __builtin_bit_cast(bf16x8, w);
              w.x = cvtpk(p0[8], p0[9]); w.y = cvtpk(p0[10], p0[11]); w.z = cvtpk(p0[12], p0[13]); w.w = cvtpk(p0[14], p0[15]); pb[1] = __builtin_bit_cast(bf16x8, w); }
            p1k = p1;
            } else {
#pragma unroll
            for (int s = 0; s < 2; ++s) { s16x4 vl[4], vh[4];
#pragma unroll
                for (int blk = 0; blk < 4; ++blk) { vl[blk] = tr16(bv + vro[blk][0] + s * 4096); vh[blk] = tr16(bv + vro[blk][1] + s * 4096); }
#pragma unroll
                for (int blk = 0; blk < 4; ++blk) { const bf16x8 va = (bf16x8){vl[blk][0], vl[blk][1], vl[blk][2], vl[blk][3], vh[blk][0], vh[blk][1], vh[blk][2], vh[blk][3]};
                    o[blk] = __builtin_amdgcn_mfma_f32_32x32x16_bf16(va, pb[s], o[blk], 0, 0, 0); } }
            bf16x8 pc2, pc3;
            { float ls1 = 0.f, ls3 = 0.f;
#pragma unroll
              for (int r = 0; r < 16; r += 2) { p1k[r] = __builtin_amdgcn_exp2f(p1k[r]); p1k[r + 1] = __builtin_amdgcn_exp2f(p1k[r + 1]); ls1 += p1k[r]; ls3 += p1k[r + 1]; }
              lrun += ls1 + ls3;
              u32x4 w;
              w.x = cvtpk(p1k[0], p1k[1]); w.y = cvtpk(p1k[2], p1k[3]); w.z = cvtpk(p1k[4], p1k[5]); w.w = cvtpk(p1k[6], p1k[7]); pc2 = __builtin_bit_cast(bf16x8, w);
              w.x = cvtpk(p1k[8], p1k[9]); w.y = cvtpk(p1k[10], p1k[11]); w.z = cvtpk(p1k[12], p1k[13]); w.w = cvtpk(p1k[14], p1k[15]); pc3 = __builtin_bit_cast(bf16x8, w); }
#pragma unroll
            for (int s = 2; s < 4; ++s) { s16x4 vl[4], vh[4];
#pragma unroll
                for (int blk = 0; blk < 4; ++blk) { vl[blk] = tr16(bv + vro[blk][0] + s * 4096); vh[blk] = tr16(bv + vro[blk][1] + s * 4096); }
#pragma unroll
                for (int blk = 0; blk < 4; ++blk) { const bf16x8 va = (bf16x8){vl[blk][0], vl[blk][1], vl[blk][2], vl[blk][3], vh[blk][0], vh[blk][1], vh[blk][2], vh[blk][3]};
                    o[blk] = __builtin_amdgcn_mfma_f32_32x32x16_bf16(va, s == 2 ? pc2 : pc3, o[blk], 0, 0, 0); } }
            }
          }
          if ((h & 3) == 3) {
              asm volatile("s_waitcnt vmcnt(0) lgkmcnt(0)" ::: "memory"); __builtin_amdgcn_s_barrier(); asm volatile("" ::: "memory"); }
        }
        asm volatile("s_waitcnt lgkmcnt(0)" ::: "memory"); __builtin_amdgcn_s_barrier(); asm volatile("" ::: "memory");
#undef AT_DMA
        const float inv = 1.0f / (lrun + __shfl_xor(lrun, 32));
        LAS float* xch = (LAS float*)(lds + rg * 16384);
        if (g == 1 && NTw > 0) {
#pragma unroll
            for (int blk = 0; blk < 4; ++blk)
#pragma unroll
                for (int r = 0; r < 16; ++r) xch[(blk * 16 + r) * 64 + lane] = o[blk][r] * inv;
        }
        __syncthreads();
        if (g == 0 && NTw > 0) {
            float ss = 0.f;
#pragma unroll
            for (int blk = 0; blk < 4; ++blk)
#pragma unroll
                for (int r = 0; r < 16; ++r) { const float v = o[blk][r] * inv - lam * xch[(blk * 16 + r) * 64 + lane]; o[blk][r] = v; ss += v * v; }
            ss += __shfl_xor(ss, 32);
            const float rn = __builtin_amdgcn_rsqf(ss * (1.0f / 128.0f) + EPS) * (1.0f - LAMBDA_INIT);
            bf16_t* op = A2 + (size_t)(qrow0 + 32 * rg + l32) * 2048 + head * 128;
            const float* gn = P.in[15];
#pragma unroll
            for (int blk = 0; blk < 4; ++blk)
#pragma unroll
                for (int rp = 0; rp < 2; ++rp) { u32x2 we, wo;
                    { const int dv = 32 * blk + 16 * rp + 4 * hi; const f32x4 gg = *(const f32x4*)(gn + dv); const int r = 8 * rp;
                      we.x = cvtpk(o[blk][r] * rn * gg[0], o[blk][r + 1] * rn * gg[1]); we.y = cvtpk(o[blk][r + 2] * rn * gg[2], o[blk][r + 3] * rn * gg[3]); }
                    { const int dv = 32 * blk + 16 * rp + 8 + 4 * hi; const f32x4 gg = *(const f32x4*)(gn + dv); const int r = 8 * rp + 4;
                      wo.x = cvtpk(o[blk][r] * rn * gg[0], o[blk][r + 1] * rn * gg[1]); wo.y = cvtpk(o[blk][r + 2] * rn * gg[2], o[blk][r + 3] * rn * gg[3]); }
                    const auto s0 = __builtin_amdgcn_permlane32_swap(we.x, wo.x, false, false), s1 = __builtin_amdgcn_permlane32_swap(we.y, wo.y, false, false);
                    u32x4 w; w.x = s0[0]; w.y = s1[0]; w.z = s0[1]; w.w = s1[1];
                    *(u32x4*)(op + 32 * blk + 16 * rp + 8 * hi) = w; }
        }
    }
    __builtin_amdgcn_s_setprio(0);
}

__device__ __forceinline__ void finalize_sample(const Params& P, const int wid_in, int S, const float* base, float scale, bf16_t* xb, float* ssq) {
    const int wave = wid_in, lane = pg8::opaque_lane();
    const int gw = blockIdx.x * NWAVES + wave, NGW = gridDim.x * NWAVES;
    const float* part = (const float*)(P.ws + WS_PART);
    for (int r = gw; r < MS; r += NGW) { const float* bp = base + (size_t)r * D_MODEL; float* op = P.out + (size_t)(MP + r) * D_MODEL; float q = 0.f;
#pragma unroll
        for (int j = 0; j < 8; ++j) { const int c = 256 * j + 4 * lane; f32x4 a = *(const f32x4*)(part + (size_t)r * D_MODEL + c);
            for (int s = 1; s < S; ++s) a += *(const f32x4*)(part + ((size_t)s * MS + r) * D_MODEL + c);
            const f32x4 o = *(const f32x4*)(bp + c) + a * scale; *(f32x4*)(op + c) = o; if (xb) *(u32x2*)(xb + (size_t)(MP + r) * D_MODEL + c) = pg8::pack4(o);
            q += (o[0] * o[0] + o[1] * o[1]) + (o[2] * o[2] + o[3] * o[3]); }
        q = wave_sum(q); if (lane == 0) ssq[MP + r] = q; }
}

constexpr int CW_PANEL = 65536;
__device__ __forceinline__ void norm_own_tiles(const Params& P, const int wid_in) {
    const int wave = wid_in, lane = pg8::opaque_lane();
    const int c = blockIdx.x, pm = 8 * (c & 7) + ((c >> 3) & 7), pn0 = c >> 6;
    unsigned* cnt = (unsigned*)(P.ws + WS_CTL) + CW_PANEL + 16 * pm;
    const float* ssq = (const float*)(P.ws + WS_CTL + 4096) + 2 * MROWS; const float* gn = P.in[22];
    asm volatile("s_waitcnt vmcnt(0)" ::: "memory"); __syncthreads();
    if (wave == 0 && lane == 0) { atomicAdd(cnt, 1u); unsigned sp = 0;
        while (__hip_atomic_load(cnt, __ATOMIC_RELAXED, __HIP_MEMORY_SCOPE_AGENT) < 4u && ++sp < (1u << 22)) __builtin_amdgcn_s_sleep(2); }
    __syncthreads();
    __builtin_amdgcn_fence(__ATOMIC_ACQUIRE, "agent");
    const f32x4 g0 = *(const f32x4*)(gn + 256 * pn0 + 4 * lane), g1 = *(const f32x4*)(gn + 256 * (pn0 + 4) + 4 * lane);
#pragma unroll 4
    for (int k = 0; k < 32; ++k) { const int row = 256 * pm + 32 * wave + k;
        const float rs = __builtin_amdgcn_rsqf(__hip_atomic_load(ssq + row, __ATOMIC_RELAXED, __HIP_MEMORY_SCOPE_AGENT) * (1.0f / D_MODEL) + EPS);
        float* xr = P.out + (size_t)row * D_MODEL + 4 * lane;
        const f32x4 v0 = *(const f32x4*)(xr + 256 * pn0), v1 = *(const f32x4*)(xr + 256 * (pn0 + 4));
        __builtin_nontemporal_store(v0 * rs * g0, (f32x4*)(xr + 256 * pn0)); __builtin_nontemporal_store(v1 * rs * g1, (f32x4*)(xr + 256 * (pn0 + 4))); }
}
__device__ __forceinline__ void final_norm_sample(const Params& P, const int wid_in) {
    const int wave = wid_in, lane = pg8::opaque_lane();
    const int gw = blockIdx.x * NWAVES + wave, NGW = gridDim.x * NWAVES;
    const float* gn = P.in[22]; const float* part = (const float*)(P.ws + WS_PART);
    for (int r = gw; r < MS; r += NGW) { float* xr = P.out + (size_t)(MP + r) * D_MODEL; f32x4 v[8]; float q = 0.f;
#pragma unroll
        for (int j = 0; j < 8; ++j) { const int cc = 256 * j + 4 * lane; f32x4 a = *(const f32x4*)(part + (size_t)r * D_MODEL + cc);
#pragma unroll
            for (int s = 1; s < 4; ++s) a += *(const f32x4*)(part + ((size_t)s * MS + r) * D_MODEL + cc);
            v[j] = *(const f32x4*)(xr + cc) + a * 0.5f; q += (v[j][0] * v[j][0] + v[j][1] * v[j][1]) + (v[j][2] * v[j][2] + v[j][3] * v[j][3]); }
        const float rs = __builtin_amdgcn_rsqf(wave_sum(q) * (1.0f / D_MODEL) + EPS);
#pragma unroll
        for (int j = 0; j < 8; ++j) { const int cc = 256 * j + 4 * lane; *(f32x4*)(xr + cc) = v[j] * rs * *(const f32x4*)(gn + cc); } }
}

#define XB_TMO      128
#define XB_XCNT(j)  (256  + 64 * (j))
#define XB_XSUB(j)  (1280 + 64 * (j))
#define XB_XGEN(j)  (2304 + 64 * (j))
#define XB_TOP      3328
#define XB_TOPGEN   3392
#define XCD_BAR_WORDS 3456
#define XB_SPIN_CAP (1u << 18)

__device__ __forceinline__ unsigned xb_ld(unsigned* p)              { return __hip_atomic_load(p, __ATOMIC_RELAXED, __HIP_MEMORY_SCOPE_AGENT); }
__device__ __forceinline__ unsigned xb_add(unsigned* p, unsigned v) { return __hip_atomic_fetch_add(p, v, __ATOMIC_RELAXED, __HIP_MEMORY_SCOPE_AGENT); }
__device__ __forceinline__ unsigned xb_xcc_id() { return (unsigned)__builtin_amdgcn_s_getreg((3 << 11) | 20) & 0xFu; }
#define XB_SPIN(cond, bar) do { unsigned _sp = 0; while (cond) { __builtin_amdgcn_s_sleep(1); \
    if ((++_sp & 255u) == 0u) { if (xb_ld(&(bar)[XB_TMO])) break; if (_sp > XB_SPIN_CAP) { atomicAdd(&(bar)[XB_TMO], 1u); break; } } } } while (0)

struct XcdBarrier {
    unsigned* bar; unsigned x;
    volatile LAS unsigned* st;
};

__device__ __forceinline__ XcdBarrier xcd_barrier_post(unsigned* bar, volatile LAS unsigned* st) {
    XcdBarrier b; b.bar = bar; b.x = xb_xcc_id(); b.st = st;
    if (threadIdx.x == 0) (void)xb_add(&bar[XB_XCNT(b.x)], 1u);
    return b;
}
__device__ __forceinline__ void xcd_barrier_complete(unsigned* bar, unsigned x, unsigned& nloc, unsigned& nx) {
    const unsigned G = gridDim.x * gridDim.y * gridDim.z;
    unsigned sum, cnt, mine, sp = 0u;
    for (;;) {
        sum = 0u; cnt = 0u; mine = 0u;
#pragma unroll
        for (unsigned j = 0; j < 16; ++j) { const unsigned c = xb_ld(&bar[XB_XCNT(j)]); sum += c; cnt += (c > 0u) ? 1u : 0u; mine = (j == x) ? c : mine; }
        if (sum == G) break;
        __builtin_amdgcn_s_sleep(1);
        if ((++sp & 255u) == 0u) { if (xb_ld(&bar[XB_TMO])) break; if (sp > XB_SPIN_CAP) { atomicAdd(&bar[XB_TMO], 1u); break; } }
    }
    nloc = mine > 0u ? mine : 1u; nx = cnt > 0u ? cnt : 1u;
}

__device__ __forceinline__ void xcd_barrier(const XcdBarrier& b) {
    asm volatile("s_waitcnt vmcnt(0)" ::: "memory");
    __syncthreads();
    if (threadIdx.x == 0) {
        unsigned* bar = b.bar;
        __builtin_amdgcn_s_waitcnt(0);
        unsigned nloc = b.st[0], nx = b.st[1];
        if (nloc == 0u) { xcd_barrier_complete(bar, b.x, nloc, nx); b.st[0] = nloc; b.st[1] = nx; }
        const unsigned old = xb_add(&bar[XB_XSUB(b.x)], 1u);
        const unsigned gen = old / nloc;
        if (old + 1u == (gen + 1u) * nloc) {
            __builtin_amdgcn_fence(__ATOMIC_RELEASE, "agent");
            asm volatile("s_waitcnt vmcnt(0)" ::: "memory");
            const unsigned og = xb_add(&bar[XB_TOP], 1u);
            const unsigned tg = og / nx;
            if (og + 1u == (tg + 1u) * nx) xb_add(&bar[XB_TOPGEN], 1u);
            else XB_SPIN(xb_ld(&bar[XB_TOPGEN]) == tg, bar);
            __builtin_amdgcn_fence(__ATOMIC_ACQUIRE, "agent");
            xb_add(&bar[XB_XGEN(b.x)], 1u);
            asm volatile("s_waitcnt vmcnt(0)" ::: "memory");
        } else {
            XB_SPIN(xb_ld(&bar[XB_XGEN(b.x)]) == gen, bar);
            __builtin_amdgcn_fence(__ATOMIC_ACQUIRE, "agent");
            asm volatile("s_waitcnt vmcnt(0)" ::: "memory");
        }
    }
    __syncthreads();
}

__global__ void __launch_bounds__(NTHREADS, 2) mega_fwd(Params P) {
    extern __shared__ __attribute__((aligned(16))) unsigned char lds_raw[];
    LAS unsigned char* lds = (LAS unsigned char*)lds_raw;
    cg::grid_group grid = cg::this_grid();
    unsigned char* ws = P.ws;
    const int G = gridDim.x, bx = blockIdx.x;
    const int wid_s = __builtin_amdgcn_readfirstlane(threadIdx.x >> 6);
    float* ssq = (float*)(ws + WS_CTL + 4096);
    bf16_t* XB = (bf16_t*)(ws + WS_XB); bf16_t* HB = (bf16_t*)(ws + WS_H);

    if (threadIdx.x < 8) ((LAS unsigned*)(lds + RING_BYTES))[threadIdx.x] = 0u;
    __syncthreads();
    prologue(P, lds, wid_s);
    grid.sync();
    const XcdBarrier bar = xcd_barrier_post((unsigned*)(ws + WS_CTL) + CW_BAR, (volatile LAS unsigned*)(lds + RING_BYTES + 16));
    { pg8::Gemm g{XB, (const bf16_t*)(ws + WS_W1GU), MROWS, 2 * FFN, D_MODEL, D_MODEL / 64}; pg8::StaticOrder S; S.init(MROWS, 2 * FFN, G, bx);
      pg8::EpiSwiGLU E{HB, FFN, nullptr};
      pg8::gemm_phase<pg8::EpiSwiGLU, pg8::StaticOrder, true, true>(lds, g, S, E, wid_s); }
    if (bx >= (68 * 44) % G) cache_convert_blocks(P, lds, wid_s, 6);
    xcd_barrier(bar);
    { pg8::Gemm g{HB, (const bf16_t*)(ws + WS_W1D), MP, D_MODEL, FFN, FFN / 64}; pg8::StaticOrder S; S.init(MP, D_MODEL, G, bx);
      pg8::EpiResid E{P.in[0], P.in[1], P.out, XB, ssq, 0.5f};
      pg8::gemm_phase<pg8::EpiResid, pg8::StaticOrder, true, true>(lds, g, S, E, wid_s); }
    { pg8::Gemm g{HB, (const bf16_t*)(ws + WS_W1D), MROWS, D_MODEL, FFN, FFN / 64 / 4}; pg8::SplitOrder S; S.init(4, FFN / 64 / 4, bx);
      pg8::EpiPartial E{(float*)(ws + WS_PART)};
      pg8::gemm_phase<pg8::EpiPartial, pg8::SplitOrder, false, true>(lds, g, S, E, wid_s);
      if ((bx >> 6) >= 2) cache_convert_blocks(P, lds, wid_s, 4); }
    xcd_barrier(bar);
    finalize_sample(P, wid_s, 4, P.in[1], 0.5f, XB, ssq);
    xcd_barrier(bar);
    { pg8::Gemm g{XB, (const bf16_t*)(ws + WS_WIN), MROWS, PROJ, D_MODEL, D_MODEL / 64}; pg8::StaticOrder S; S.init(MROWS, PROJ, G, bx);
      const float* cosT = (const float*)(ws + WS_ROPE);
      pg8::EpiProj E{ssq, cosT, cosT + 4096 * 32, (bf16_t*)(ws + WS_Q), (bf16_t*)(ws + WS_KP), (bf16_t*)(ws + WS_VP), (bf16_t*)(ws + WS_KS), (bf16_t*)(ws + WS_VS), (bf16_t*)(ws + WS_CB), (bf16_t*)(ws + WS_U),
                     P.out + O_KP, P.out + O_VP, P.out + O_KS, P.out + O_VS, P.out + O_CP, P.out + O_CS};
      pg8::gemm_phase<pg8::EpiProj, pg8::StaticOrder, true, true>(lds, g, S, E, wid_s); }
    if (bx >= (68 * 24) % G) cache_convert_blocks(P, lds, wid_s, 6);
    cache_convert_blocks(P, lds, wid_s, CV_BLOCKS);
    xcd_barrier(bar);
    conv_phase(P, wid_s);
    attn_phase(P, lds, wid_s);
    xcd_barrier(bar);
    { pg8::Gemm g{(const bf16_t*)(ws + WS_A2), (const bf16_t*)(ws + WS_WOUT), MP, D_MODEL, D_MODEL, D_MODEL / 64}; pg8::StaticOrder S; S.init(MP, D_MODEL, G, bx);
      pg8::EpiResid E{P.out, P.out + (size_t)MP * D_MODEL, P.out, XB, ssq + MROWS, 1.0f};
      pg8::gemm_phase<pg8::EpiResid, pg8::StaticOrder, true, true>(lds, g, S, E, wid_s); }
    { pg8::Gemm g{(const bf16_t*)(ws + WS_A2), (const bf16_t*)(ws + WS_WOUT), MROWS, D_MODEL, D_MODEL, D_MODEL / 64 / 8}; pg8::SplitOrder S; S.init(8, D_MODEL / 64 / 8, bx);
      pg8::EpiPartial E{(float*)(ws + WS_PART)};
      pg8::gemm_phase<pg8::EpiPartial, pg8::SplitOrder, false, true>(lds, g, S, E, wid_s); }
    xcd_barrier(bar);
    finalize_sample(P, wid_s, 8, P.out + (size_t)MP * D_MODEL, 1.0f, XB, ssq + MROWS);
    xcd_barrier(bar);
    { pg8::Gemm g{XB, (const bf16_t*)(ws + WS_W2GU), MROWS, 2 * FFN, D_MODEL, D_MODEL / 64}; pg8::StaticOrder S; S.init(MROWS, 2 * FFN, G, bx);
      pg8::EpiSwiGLU E{HB, FFN, ssq + MROWS};
      pg8::gemm_phase<pg8::EpiSwiGLU, pg8::StaticOrder, true, true>(lds, g, S, E, wid_s); }
    xcd_barrier(bar);
    { pg8::Gemm g{HB, (const bf16_t*)(ws + WS_W2D), MP, D_MODEL, FFN, FFN / 64}; pg8::StaticOrder S; S.init(MP, D_MODEL, G, bx);
      pg8::EpiResid E{P.out, P.out + (size_t)MP * D_MODEL, P.out, nullptr, ssq + 2 * MROWS, 0.5f};
      pg8::gemm_phase<pg8::EpiResid, pg8::StaticOrder, true, true>(lds, g, S, E, wid_s); }
    { pg8::Gemm g{HB, (const bf16_t*)(ws + WS_W2D), MROWS, D_MODEL, FFN, FFN / 64 / 4}; pg8::SplitOrder S; S.init(4, FFN / 64 / 4, bx);
      pg8::EpiPartial E{(float*)(ws + WS_PART)};
      pg8::gemm_phase<pg8::EpiPartial, pg8::SplitOrder, false, true>(lds, g, S, E, wid_s); }
    if (G == 256) norm_own_tiles(P, wid_s);
    xcd_barrier(bar);
    final_norm_sample(P, wid_s);
    if (G != 256) { const int lane = pg8::opaque_lane(); const float* ssqc = ssq + 2 * MROWS; const float* gn = P.in[22];
        for (int m = bx * NWAVES + wid_s; m < MP; m += G * NWAVES) { float* xr = P.out + (size_t)m * D_MODEL; const float rs = __builtin_amdgcn_rsqf(ssqc[m] * (1.0f / D_MODEL) + EPS);
            for (int j = 0; j < 8; ++j) { const f32x4 v = *(const f32x4*)(xr + 256 * j + 4 * lane), gg = *(const f32x4*)(gn + 256 * j + 4 * lane); *(f32x4*)(xr + 256 * j + 4 * lane) = v * rs * gg; } } }
}

extern "C" void kernel_launch(void* const* d_in, const int* in_sizes, int n_in, void* d_out, int out_size, void* d_ws, size_t ws_size, hipStream_t stream) {
    static int grid = 0;
    if (grid == 0) {
        if (n_in != 23 || (size_t)out_size != O_END || ws_size < WS_END) { fprintf(stderr, "kernel_launch: unexpected shapes (n_in %d out %d ws %zu)\n", n_in, out_size, ws_size); grid = -1; return; }
        int dev = 0, cus = 0, per_cu = 0;
        hipGetDevice(&dev); hipDeviceGetAttribute(&cus, hipDeviceAttributeMultiprocessorCount, dev);
        if (hipFuncSetAttribute((const void*)mega_fwd, hipFuncAttributeMaxDynamicSharedMemorySize, LDS_BYTES) != hipSuccess) { fprintf(stderr, "kernel_launch: hipFuncSetAttribute failed\n"); grid = -1; return; }
        if (hipOccupancyMaxActiveBlocksPerMultiprocessor(&per_cu, (const void*)mega_fwd, NTHREADS, LDS_BYTES) != hipSuccess || per_cu < 1) { fprintf(stderr, "kernel_launch: occupancy query says %d\n", per_cu); per_cu = 1; }
        (void)hipGetLastError();
        grid = cus;
        fprintf(stderr, "kernel_launch: grid %d (per_cu %d)\n", grid, per_cu);
    }
    if (grid < 0) return;
    Params p{};
    for (int i = 0; i < 23; ++i) p.in[i] = (const float*)d_in[i];
    p.out = (float*)d_out; p.ws = (unsigned char*)d_ws;
    void* args[] = {&p};
    hipError_t e = hipLaunchCooperativeKernel((const void*)mega_fwd, dim3(grid), dim3(NTHREADS), args, LDS_BYTES, stream);
    if (e != hipSuccess) fprintf(stderr, "cooperative launch failed: %s (grid %d)\n", hipGetErrorString(e), grid);
}
```
